# Optimizing an MI355X kernel written in HIP

```python
import jax, jax.numpy as jnp
from jax import lax
import numpy as np

D_MODEL = 1024
BATCH = 8
SEQ = 4096
DEPTH = 1

MEM_LEN = 256
NORM_EPS = 1e-6
HALF_STEP = 0.5
D_FF = 2816

RWKV_HEADS = 8
RWKV_HEAD_DIM = 64
RWKV_WIDTH = RWKV_HEADS * RWKV_HEAD_DIM
DECAY_LORA = 64
AAA_LORA = 64
GATE_LORA = 128
RWKV_GN_EPS = 64e-5
RWKV_SIZES = (RWKV_WIDTH, RWKV_WIDTH, RWKV_WIDTH, DECAY_LORA, AAA_LORA, GATE_LORA)
RWKV_COLS = 3 * RWKV_WIDTH + DECAY_LORA + AAA_LORA + GATE_LORA

SWA_Q_HEADS = 8
SWA_KV_HEADS = 2
SWA_GROUP = SWA_Q_HEADS // SWA_KV_HEADS
SWA_HEAD_DIM = 64
SWA_SIZES = (SWA_Q_HEADS * SWA_HEAD_DIM, SWA_KV_HEADS * SWA_HEAD_DIM, SWA_KV_HEADS * SWA_HEAD_DIM)
SWA_COLS = SWA_Q_HEADS * SWA_HEAD_DIM + 2 * SWA_KV_HEADS * SWA_HEAD_DIM
WINDOW = 128
BLOCK = 128
ROPE_THETA = 500000.0
ROPE_DIM = SWA_HEAD_DIM // 4

MEM_HEADS = 4
MEM_HEAD_DIM = 128
MEM_WIDTH = MEM_HEADS * MEM_HEAD_DIM

N_BRANCH = 3
BRANCH_WIDTH = 512
IN_SIZES = (RWKV_COLS, SWA_COLS, MEM_WIDTH, N_BRANCH * D_MODEL)
IN_COLS = RWKV_COLS + SWA_COLS + MEM_WIDTH + N_BRANCH * D_MODEL
NEG_INF = -1e30

kernel_name = 'hybrid_rwkv7_swa_sink_memxattn_macaron'


def _split(t, sizes):
    out, start = [], 0
    for s in sizes:
        out.append(t[..., start:start + s])
        start += s
    return out


def rms_norm(x, g):
    xf = x.astype(jnp.float32)
    y = xf * lax.rsqrt(jnp.mean(xf * xf, axis=-1, keepdims=True) + NORM_EPS)
    return (y * g.astype(jnp.float32)).astype(x.dtype)


def swiglu(u, w_in, w_out):
    gate, up = jnp.split(u @ w_in, 2, axis=-1)
    return (jax.nn.silu(gate) * up) @ w_out


def rope_tables(positions):
    inv_freq = ROPE_THETA ** (-jnp.arange(0, ROPE_DIM, 2, dtype=jnp.float32) / ROPE_DIM)
    ang = positions.astype(jnp.float32)[..., None] * inv_freq
    return jnp.cos(ang)[:, :, None, :], jnp.sin(ang)[:, :, None, :]


def partial_rope(t, cos, sin):
    half = ROPE_DIM // 2
    tf = t[..., :ROPE_DIM].astype(jnp.float32)
    x1, x2 = tf[..., :half], tf[..., half:]
    rot = jnp.concatenate([x1 * cos - x2 * sin, x2 * cos + x1 * sin], axis=-1)
    return jnp.concatenate([rot.astype(t.dtype), t[..., ROPE_DIM:]], axis=-1)


def rwkv7_recurrence(r, decay, k, v, a, b):
    def step(state, inp):
        r_t, w_t, k_t, v_t, a_t, b_t = inp
        sa = jnp.einsum('bhvk,bhk->bhv', state, a_t)
        state = (state * w_t[:, :, None, :] + sa[..., None] * b_t[:, :, None, :]
                 + v_t[..., None] * k_t[:, :, None, :])
        return state, jnp.einsum('bhvk,bhk->bhv', state, r_t)

    xs = (jnp.swapaxes(r, 0, 1), jnp.swapaxes(decay, 0, 1), jnp.swapaxes(k, 0, 1),
          jnp.swapaxes(v, 0, 1), jnp.swapaxes(a, 0, 1), jnp.swapaxes(b, 0, 1))
    B, _, H, N = r.shape
    s0 = jnp.zeros((B, H, N, N), jnp.float32)
    _, y = lax.scan(step, s0, xs)
    return jnp.swapaxes(y, 0, 1)


def rwkv7_mix(p, mu, w0, w_up, a0, a_up, g_up, k_k, k_a, r_k, gn_g, gn_b):
    f32 = jnp.float32
    B, S, _ = p.shape
    H, N = RWKV_HEADS, RWKV_HEAD_DIM
    p_prev = jnp.pad(p, ((0, 0), (1, 0), (0, 0)))[:, :-1]
    p = p + (p_prev - p) * mu
    r, k, v, wd, ad, gd = _split(p, RWKV_SIZES)
    w_log = -jax.nn.softplus(-(w0 + jnp.tanh(wd) @ w_up).astype(f32)) - 0.5
    decay = jnp.exp(-jnp.exp(w_log))
    a = jax.nn.sigmoid((a0 + ad @ a_up).astype(f32))
    g = (jax.nn.sigmoid(gd) @ g_up).astype(f32)
    r = r.astype(f32)
    k = k.astype(f32)
    v = v.astype(f32)
    kk = (k * k_k.astype(f32)).reshape(B, S, H, N)
    kk = kk / jnp.maximum(jnp.sqrt(jnp.sum(kk * kk, axis=-1, keepdims=True)), 1e-12)
    k = k * (1.0 + (a - 1.0) * k_a.astype(f32))
    r = r.reshape(B, S, H, N)
    k = k.reshape(B, S, H, N)
    v = v.reshape(B, S, H, N)
    a = a.reshape(B, S, H, N)
    decay = decay.reshape(B, S, H, N)
    y = rwkv7_recurrence(r, decay, k, v, -kk, kk * a)
    mean = jnp.mean(y, axis=-1, keepdims=True)
    var = jnp.mean(jnp.square(y - mean), axis=-1, keepdims=True)
    y = ((y - mean) * lax.rsqrt(var + RWKV_GN_EPS) * gn_g.astype(f32).reshape(H, N)
         + gn_b.astype(f32).reshape(H, N))
    y = y + jnp.sum(r * k * r_k.astype(f32), axis=-1, keepdims=True) * v
    return (y.reshape(B, S, RWKV_WIDTH) * g).astype(p.dtype)


def sliding_window_gqa_sinks(q, k, v, sinks):
    f32 = jnp.float32
    B, S = q.shape[0], q.shape[1]
    nb = S // BLOCK
    scale = SWA_HEAD_DIM ** -0.5
    qb = q.astype(f32).reshape(B, nb, BLOCK, SWA_KV_HEADS, SWA_GROUP, SWA_HEAD_DIM) * scale

    def banded(t):
        tb = t.astype(f32).reshape(B, nb, BLOCK, SWA_KV_HEADS, SWA_HEAD_DIM)
        prev = jnp.pad(tb, ((0, 0), (1, 0), (0, 0), (0, 0), (0, 0)))[:, :-1]
        return jnp.concatenate([prev, tb], axis=2)

    kw, vw = banded(k), banded(v)
    s = jnp.einsum('bnqhgd,bnkhd->bnhgqk', qb, kw)
    qi = jnp.arange(BLOCK)
    kj = jnp.arange(2 * BLOCK)
    blk = jnp.arange(nb)
    diff = qi[:, None] + BLOCK - kj[None, :]
    valid = (diff >= 0) & (diff < WINDOW)
    key_pos = blk[:, None] * BLOCK - BLOCK + kj[None, :]
    valid = valid[None, :, :] & (key_pos >= 0)[:, None, :]
    s = jnp.where(valid[None, :, None, None], s, NEG_INF)
    sink = sinks.astype(f32).reshape(SWA_KV_HEADS, SWA_GROUP)[None, None, :, :, None, None]
    sink = jnp.broadcast_to(sink, s.shape[:-1] + (1,))
    pr = jax.nn.softmax(jnp.concatenate([s, sink], axis=-1), axis=-1)[..., :-1]
    o = jnp.einsum('bnhgqk,bnkhd->bnqhgd', pr, vw)
    return o.reshape(B, S, SWA_Q_HEADS * SWA_HEAD_DIM).astype(q.dtype)


def memory_cross_attention(q, mem_n, w_kv):
    f32 = jnp.float32
    B, S = q.shape[0], q.shape[1]
    km, vm = jnp.split(mem_n @ w_kv, 2, axis=-1)
    km = km.reshape(B, -1, MEM_HEADS, MEM_HEAD_DIM).astype(f32)
    vm = vm.reshape(B, -1, MEM_HEADS, MEM_HEAD_DIM).astype(f32)
    s = jnp.einsum('bshd,bmhd->bhsm', q.astype(f32) * MEM_HEAD_DIM ** -0.5, km)
    pr = jax.nn.softmax(s, axis=-1)
    o = jnp.einsum('bhsm,bmhd->bshd', pr, vm)
    return o.reshape(B, S, MEM_WIDTH).astype(q.dtype)


def setup_inputs(seed: int = 0) -> dict:
    key = jax.random.key(seed)
    ks = iter(jax.random.split(key, 40))
    f32 = jnp.float32
    L, D = DEPTH, D_MODEL

    def nrm(shape, scale):
        return scale * jax.random.normal(next(ks), shape, f32)

    def gain(n):
        return 1.0 + 0.05 * jax.random.normal(next(ks), (L, n), f32)

    x = jax.random.normal(next(ks), (BATCH, SEQ, D), f32)
    mem = jax.random.normal(next(ks), (BATCH, MEM_LEN, D), f32)
    start = jax.random.randint(next(ks), (BATCH, 1), 0, 1024, dtype=jnp.int32)
    positions = start + jnp.arange(SEQ, dtype=jnp.int32)[None, :]
    return {
        'x': x,
        'mem': mem,
        'positions': positions,
        'ffn1_pre_g': gain(D),
        'ffn1_w_in': nrm((L, D, 2 * D_FF), D ** -0.5),
        'ffn1_w_out': nrm((L, D_FF, D), D_FF ** -0.5),
        'ffn1_post_g': gain(D),
        'mix_pre_g': gain(D),
        'w_in': nrm((L, D, IN_COLS), D ** -0.5),
        'gate_b': nrm((L, N_BRANCH * D), 0.1),
        'rwkv_mu': jax.random.uniform(next(ks), (L, RWKV_COLS), f32),
        'rwkv_w0': jax.random.uniform(next(ks), (L, RWKV_WIDTH), f32, -3.0, 3.0),
        'rwkv_w_up': nrm((L, DECAY_LORA, RWKV_WIDTH), 0.1),
        'rwkv_a0': nrm((L, RWKV_WIDTH), 0.5),
        'rwkv_a_up': nrm((L, AAA_LORA, RWKV_WIDTH), 0.1),
        'rwkv_g_up': nrm((L, GATE_LORA, RWKV_WIDTH), GATE_LORA ** -0.5),
        'rwkv_k_k': 0.85 + nrm((L, RWKV_WIDTH), 0.05),
        'rwkv_k_a': 1.0 + nrm((L, RWKV_WIDTH), 0.05),
        'rwkv_r_k': nrm((L, RWKV_HEADS, RWKV_HEAD_DIM), 0.1),
        'rwkv_gn_g': gain(RWKV_WIDTH),
        'rwkv_gn_b': nrm((L, RWKV_WIDTH), 0.01),
        'swa_sinks': nrm((L, SWA_Q_HEADS), 1.0),
        'mem_norm_g': gain(D),
        'mem_w_kv': nrm((L, D, 2 * MEM_WIDTH), D ** -0.5),
        'w_branch': nrm((L, N_BRANCH, BRANCH_WIDTH, D), BRANCH_WIDTH ** -0.5),
        'w_out': nrm((L, D, D), D ** -0.5),
        'mix_post_g': gain(D),
        'ffn2_pre_g': gain(D),
        'ffn2_w_in': nrm((L, D, 2 * D_FF), D ** -0.5),
        'ffn2_w_out': nrm((L, D_FF, D), D_FF ** -0.5),
        'ffn2_post_g': gain(D),
    }


def reference(x, mem, positions, ffn1_pre_g, ffn1_w_in, ffn1_w_out, ffn1_post_g,
              mix_pre_g, w_in, gate_b, rwkv_mu, rwkv_w0, rwkv_w_up, rwkv_a0, rwkv_a_up,
              rwkv_g_up, rwkv_k_k, rwkv_k_a, rwkv_r_k, rwkv_gn_g, rwkv_gn_b, swa_sinks,
              mem_norm_g, mem_w_kv, w_branch, w_out, mix_post_g,
              ffn2_pre_g, ffn2_w_in, ffn2_w_out, ffn2_post_g):
    B, S, D = x.shape
    cos, sin = rope_tables(positions)
    h = x
    for l in range(DEPTH):
        f1 = swiglu(rms_norm(h, ffn1_pre_g[l]), ffn1_w_in[l], ffn1_w_out[l])
        h = h + HALF_STEP * rms_norm(f1, ffn1_post_g[l])

        u = rms_norm(h, mix_pre_g[l])
        p_rwkv, p_swa, q_mem, gate_logits = _split(u @ w_in[l], IN_SIZES)

        y_a = rwkv7_mix(p_rwkv, rwkv_mu[l], rwkv_w0[l], rwkv_w_up[l], rwkv_a0[l],
                        rwkv_a_up[l], rwkv_g_up[l], rwkv_k_k[l], rwkv_k_a[l], rwkv_r_k[l],
                        rwkv_gn_g[l], rwkv_gn_b[l])

        q_s, k_s, v_s = _split(p_swa, SWA_SIZES)
        q_s = partial_rope(q_s.reshape(B, S, SWA_Q_HEADS, SWA_HEAD_DIM), cos, sin)
        k_s = partial_rope(k_s.reshape(B, S, SWA_KV_HEADS, SWA_HEAD_DIM), cos, sin)
        v_s = v_s.reshape(B, S, SWA_KV_HEADS, SWA_HEAD_DIM)
        y_b = sliding_window_gqa_sinks(q_s, k_s, v_s, swa_sinks[l])

        mem_n = rms_norm(mem, mem_norm_g[l])
        y_c = memory_cross_attention(q_mem.reshape(B, S, MEM_HEADS, MEM_HEAD_DIM),
                                     mem_n, mem_w_kv[l])

        g_a, g_b, g_c = _split(jax.nn.sigmoid(gate_logits + gate_b[l]), (D, D, D))
        merged = (g_a * (y_a @ w_branch[l, 0]) + g_b * (y_b @ w_branch[l, 1])
                  + g_c * (y_c @ w_branch[l, 2]))
        h = h + rms_norm(merged @ w_out[l], mix_post_g[l])

        f2 = swiglu(rms_norm(h, ffn2_pre_g[l]), ffn2_w_in[l], ffn2_w_out[l])
        h = h + HALF_STEP * rms_norm(f2, ffn2_post_g[l])
    return h
```

```cpp
#include <hip/hip_runtime.h>
#include <cstdio>
#include <cstdint>
#include <cmath>
namespace pg8 {
#define PG8_LAS __attribute__((address_space(3)))
typedef unsigned short bf16_t;
typedef short bf16x8 __attribute__((ext_vector_type(8)));
typedef float f32x4 __attribute__((ext_vector_type(4)));
typedef unsigned u32x4 __attribute__((ext_vector_type(4)));
constexpr int BM = 256, BK = 64, HALF = 128, HTB = HALF * BK * 2  , STAGE_BYTES = 8 * HTB, NXCD = 8, WGM = 8;

__host__ __device__ __forceinline__ int lds_byte(int r, int c) { const int st = (r >> 4) * 2 + (c >> 5), rr = r & 15, cc = c & 31, ob = rr * 64 + cc * 2; return st * 1024 + (ob ^ (((ob >> 9) & 1) << 5)); }
__host__ __device__ __forceinline__ void stage_rc(int b, int& R, int& C) { const int st = b / 1024, sb = b % 1024, swz = sb ^ (((sb >> 9) & 1) << 5); R = (st >> 1) * 16 + swz / 64; C = (st & 1) * 32 + (swz % 64) / 2; }
__host__ __device__ __forceinline__ int perm32(int rho) { const int n = rho >> 4, i = rho & 15; return 8 * (i >> 2) + 4 * n + (i & 3); }

struct Unit { int pm, pn; };
struct Gemm { const bf16_t* A; const bf16_t* Bt; int M, N, K; };

struct StaticOrder {
    int nM, nN, nwg, G, c;
    __host__ __device__ void init(int M, int N, int G_, int c_) { nM = M / BM; nN = N / BM; nwg = nM * nN; G = G_; c = c_; }
    __host__ __device__ bool next(int i, Unit& u) const {
        const long L = (long)i * G + c; if (L >= nwg) return false;
        int wgid = (int)L; { const int q = nwg / NXCD, r = nwg % NXCD, xcd = wgid % NXCD, off = wgid / NXCD; wgid = (xcd < r ? xcd * (q + 1) : r * (q + 1) + (xcd - r) * q) + off; }
        const int nig = WGM * nN, gid = wgid / nig, fm = gid * WGM, gsz = (nM - fm) < WGM ? (nM - fm) : WGM;
        u.pm = fm + ((wgid % nig) % gsz); u.pn = (wgid % nig) / gsz; return true;
    }
    __device__ __forceinline__ void a_ready(const Unit&) const {}
    __device__ __forceinline__ void done(const Unit&) const {}
};

__device__ __forceinline__ unsigned cvt_pk_bf16(float lo, float hi) { unsigned r; asm volatile("v_cvt_pk_bf16_f32 %0, %1, %2" : "=v"(r) : "v"(lo), "v"(hi)); return r; }
typedef float f32x2 __attribute__((ext_vector_type(2)));
__device__ __forceinline__ float sigmoidf_(float x) { return 1.0f / (1.0f + __expf(-x)); }
__device__ __forceinline__ float bf2f(bf16_t v) { return __uint_as_float(((unsigned)v) << 16); }
struct EpiSwiglu {
    static constexpr bool PERM = true, AFTER_DRAIN = false;
    bf16_t* O; int ldc;
    __device__ __forceinline__ void operator()(const f32x4 (&acc)[2][2][4][2], const Unit& u, int wr, int wc, int fr, int fq) const {
        const int row0 = u.pm * BM + wr * 64 + fr, col0 = u.pn * HALF + wc * 32 + 8 * fq;
#pragma unroll
        for (int ai = 0; ai < 2; ++ai)
#pragma unroll
            for (int m = 0; m < 4; ++m) { bf16_t* rowp = O + (size_t)(row0 + ai * HALF + m * 16) * ldc + col0;
                float o[8];
#pragma unroll
                for (int n = 0; n < 2; ++n)
#pragma unroll
                    for (int i = 0; i < 4; ++i) { const float g = acc[ai][0][m][n][i], up = acc[ai][1][m][n][i]; o[4 * n + i] = g * sigmoidf_(g) * up; }
                u32x4 w; w.x = cvt_pk_bf16(o[0], o[1]); w.y = cvt_pk_bf16(o[2], o[3]); w.z = cvt_pk_bf16(o[4], o[5]); w.w = cvt_pk_bf16(o[6], o[7]);
                *(u32x4*)rowp = w; }
    }
};
struct EpiF32 {
    static constexpr bool PERM = false, AFTER_DRAIN = false;
    float* O; int ldc;
    __device__ __forceinline__ void operator()(const f32x4 (&acc)[2][2][4][2], const Unit& u, int wr, int wc, int fr, int fq) const {
        const int row0 = u.pm * BM + wr * 64 + fr, col0 = u.pn * BM + wc * 32 + 4 * fq;
#pragma unroll
        for (int ai = 0; ai < 2; ++ai)
#pragma unroll
            for (int m = 0; m < 4; ++m) { float* rowp = O + (size_t)(row0 + ai * HALF + m * 16) * ldc + col0;
#pragma unroll
                for (int bj = 0; bj < 2; ++bj)
#pragma unroll
                    for (int n = 0; n < 2; ++n) *(f32x4*)(rowp + bj * HALF + n * 16) = acc[ai][bj][m][n]; }
    }
};
struct EpiBf16Plain {
    static constexpr bool PERM = true, AFTER_DRAIN = false;
    bf16_t* O; int ldc;
    __device__ __forceinline__ void operator()(const f32x4 (&acc)[2][2][4][2], const Unit& u, int wr, int wc, int fr, int fq) const {
        const int row0 = u.pm * BM + wr * 64 + fr, col0 = u.pn * BM + wc * 32 + 8 * fq;
#pragma unroll
        for (int ai = 0; ai < 2; ++ai)
#pragma unroll
            for (int m = 0; m < 4; ++m) { bf16_t* rowp = O + (size_t)(row0 + ai * HALF + m * 16) * ldc + col0;
#pragma unroll
                for (int bj = 0; bj < 2; ++bj) { const f32x4 v0 = acc[ai][bj][m][0], v1 = acc[ai][bj][m][1];
                    u32x4 w; w.x = cvt_pk_bf16(v0[0], v0[1]); w.y = cvt_pk_bf16(v0[2], v0[3]); w.z = cvt_pk_bf16(v1[0], v1[1]); w.w = cvt_pk_bf16(v1[2], v1[3]);
                    *(u32x4*)(rowp + bj * HALF) = w; } }
    }
};
struct EpiProj {
    static constexpr bool PERM = true, AFTER_DRAIN = false;
    bf16_t *Prw, *Qs, *KVs, *Qm, *Gt; const float* gate_b;
    __device__ __forceinline__ void operator()(const f32x4 (&acc)[2][2][4][2], const Unit& u, int wr, int wc, int fr, int fq) const {
        bf16_t* base; int ldc, colt; const int pn = u.pn; bool gate = false;
        if (pn < 7) { base = Prw; ldc = 1792; colt = 256 * pn; }
        else if (pn < 9) { base = Qs; ldc = 512; colt = 256 * (pn - 7); }
        else if (pn < 10) { base = KVs; ldc = 256; colt = 0; }
        else if (pn < 12) { base = Qm; ldc = 512; colt = 256 * (pn - 10); }
        else { base = Gt; ldc = 3072; colt = 256 * (pn - 12); gate = true; }
        const int row0 = u.pm * BM + wr * 64 + fr, col0 = colt + wc * 32 + 8 * fq;
        f32x4 bv[2][2];
#pragma unroll
        for (int bj = 0; bj < 2; ++bj)
#pragma unroll
            for (int n = 0; n < 2; ++n) bv[bj][n] = gate ? *(const f32x4*)(gate_b + col0 + bj * HALF + 4 * n) : (f32x4){0.f, 0.f, 0.f, 0.f};
#pragma unroll
        for (int ai = 0; ai < 2; ++ai)
#pragma unroll
            for (int m = 0; m < 4; ++m) { bf16_t* rowp = base + (size_t)(row0 + ai * HALF + m * 16) * ldc + col0;
#pragma unroll
                for (int bj = 0; bj < 2; ++bj) { f32x4 v0 = acc[ai][bj][m][0] + bv[bj][0], v1 = acc[ai][bj][m][1] + bv[bj][1];
                    if (gate) {
#pragma unroll
                        for (int i = 0; i < 4; ++i) { v0[i] = sigmoidf_(v0[i]); v1[i] = sigmoidf_(v1[i]); } }
                    u32x4 w; w.x = cvt_pk_bf16(v0[0], v0[1]); w.y = cvt_pk_bf16(v0[2], v0[3]); w.z = cvt_pk_bf16(v1[0], v1[1]); w.w = cvt_pk_bf16(v1[2], v1[3]);
                    *(u32x4*)(rowp + bj * HALF) = w; } }
    }
};
struct EpiMerge {
    static constexpr bool PERM = true, AFTER_DRAIN = false;
    bf16_t* O; const bf16_t* G; int gcol; int first;
    __device__ __forceinline__ void operator()(const f32x4 (&acc)[2][2][4][2], const Unit& u, int wr, int wc, int fr, int fq) const {
        const int row0 = u.pm * BM + wr * 64 + fr, col0 = u.pn * BM + wc * 32 + 8 * fq;
#pragma unroll
        for (int ai = 0; ai < 2; ++ai)
#pragma unroll
            for (int m = 0; m < 4; ++m) { const size_t r = (size_t)(row0 + ai * HALF + m * 16);
#pragma unroll
                for (int bj = 0; bj < 2; ++bj) {
                    const u32x4 gw = *(const u32x4*)(G + r * 3072 + gcol + col0 + bj * HALF);
                    u32x4 ow = (u32x4){0u, 0u, 0u, 0u}; if (!first) ow = *(const u32x4*)(O + r * 1024 + col0 + bj * HALF);
                    float o[8];
#pragma unroll
                    for (int q = 0; q < 4; ++q) { const unsigned g2 = gw[q], o2 = ow[q];
                        const float a0 = acc[ai][bj][m][q >> 1][(q & 1) * 2], a1 = acc[ai][bj][m][q >> 1][(q & 1) * 2 + 1];
                        o[2 * q] = __uint_as_float(o2 << 16) + __uint_as_float(g2 << 16) * a0;
                        o[2 * q + 1] = __uint_as_float(o2 & 0xffff0000u) + __uint_as_float(g2 & 0xffff0000u) * a1; }
                    u32x4 w; w.x = cvt_pk_bf16(o[0], o[1]); w.y = cvt_pk_bf16(o[2], o[3]); w.z = cvt_pk_bf16(o[4], o[5]); w.w = cvt_pk_bf16(o[6], o[7]);
                    *(u32x4*)(O + r * 1024 + col0 + bj * HALF) = w; } }
    }
};
template <class Epi, class Sched, bool ALIGN_EPI = false, bool SP2 = false>
__device__ __forceinline__ void gemm_phase(PG8_LAS unsigned char* lds, const Gemm g, const Sched& S, const Epi& E) {
    int tid_ = threadIdx.x; asm volatile("" : "+v"(tid_));
    const int tid = tid_, wid = __builtin_amdgcn_readfirstlane(tid >> 6), lane = tid & 63, wr = wid >> 2, wc = wid & 3, fr = lane & 15, fq = lane >> 4;
    const int K = g.K, nt = K / BK;
    unsigned voffA[2], voffB[2];
#pragma unroll
    for (int i = 0; i < 2; ++i) { int R, C; stage_rc(tid * 16 + i * 8192, R, C); const int Rb = Epi::PERM ? ((R & ~31) + perm32(R & 31)) : R;
        voffA[i] = (unsigned)(R * K + C) * 2u; voffB[i] = (unsigned)(Rb * K + C) * 2u; }
    const size_t kstep = (size_t)(BK * 2);
    const size_t hstep = (size_t)HALF * K * 2;
    const size_t tstep = 2 * hstep;
    const unsigned ldsw = (unsigned)wid * 1024u;
    const int aoff = lds_byte(wr * 64 + fr, fq * 8), boff = lds_byte(wc * 32 + fr, fq * 8);
#define PG8_SA(b, h) (((b) * 2 + (h)) * HTB)
#define PG8_SB(b, h) ((4 + (b) * 2 + (h)) * HTB)
#define PG8_STAGE(bufoff, gbase, voff) do { _Pragma("unroll") for (int _i = 0; _i < 2; ++_i) \
        __builtin_amdgcn_global_load_lds((const unsigned*)((const char*)(gbase) + (voff)[_i]), (PG8_LAS unsigned*)(lds + (bufoff) + ldsw + _i * 8192), 16, 0, 0); } while (0)
#define PG8_LDA(dst, b, h) do { _Pragma("unroll") for (int m = 0; m < 4; ++m) _Pragma("unroll") for (int k = 0; k < 2; ++k) dst[m][k] = *(const PG8_LAS bf16x8*)(lds + PG8_SA(b, h) + aoff + m * 2048 + k * 1024); } while (0)
#define PG8_LDB(dst, b, h) do { _Pragma("unroll") for (int n = 0; n < 2; ++n) _Pragma("unroll") for (int k = 0; k < 2; ++k) dst[n][k] = *(const PG8_LAS bf16x8*)(lds + PG8_SB(b, h) + boff + n * 2048 + k * 1024); } while (0)
#define PG8_MMA(ai, bj, At, Bt) do { __builtin_amdgcn_s_setprio(1); _Pragma("unroll") for (int m = 0; m < 4; ++m) _Pragma("unroll") for (int n = 0; n < 2; ++n) _Pragma("unroll") for (int k = 0; k < 2; ++k) \
        acc[ai][bj][m][n] = __builtin_amdgcn_mfma_f32_16x16x32_bf16(Bt[n][k], At[m][k], acc[ai][bj][m][n], 0, 0, 0); __builtin_amdgcn_s_setprio(0); } while (0)
#define PG8_WAIT_V(n) asm volatile("s_waitcnt vmcnt(" #n ")" ::: "memory")
#define PG8_WAIT_L(n) asm volatile("s_waitcnt lgkmcnt(" #n ")" ::: "memory")
#define PG8_BAR __builtin_amdgcn_s_barrier()
#define PG8_SCHED __builtin_amdgcn_sched_barrier(0)
    Unit cur, nxt; int ui = 0;
    if (!S.next(0, cur)) return;
    f32x4 acc[2][2][4][2];
#pragma unroll
    for (int a = 0; a < 2; ++a)
#pragma unroll
        for (int b = 0; b < 2; ++b)
#pragma unroll
            for (int m = 0; m < 4; ++m)
#pragma unroll
                for (int n = 0; n < 2; ++n) acc[a][b][m][n] = (f32x4){0.f, 0.f, 0.f, 0.f};
    bf16x8 At[4][2], B0[2][2], B1[2][2];
    const char* cA = (const char*)g.A + (size_t)cur.pm * tstep; const char* cB = (const char*)g.Bt + (size_t)cur.pn * tstep;
    S.a_ready(cur);
    if constexpr (SP2) {
        PG8_STAGE(PG8_SB(0, 0), cB, voffB); PG8_STAGE(PG8_SB(0, 1), cB + hstep, voffB); PG8_STAGE(PG8_SA(0, 0), cA, voffA); PG8_STAGE(PG8_SA(0, 1), cA + hstep, voffA);
        if (wr == 1) PG8_BAR;
        PG8_WAIT_V(2); PG8_BAR;
        PG8_STAGE(PG8_SB(1, 0), cB + kstep, voffB); PG8_STAGE(PG8_SA(1, 0), cA + kstep, voffA); PG8_STAGE(PG8_SB(1, 1), cB + hstep + kstep, voffB);
        PG8_WAIT_V(6); PG8_BAR;
    } else {
        PG8_STAGE(PG8_SB(0, 0), cB, voffB); PG8_STAGE(PG8_SA(0, 0), cA, voffA); PG8_STAGE(PG8_SB(0, 1), cB + hstep, voffB); PG8_STAGE(PG8_SA(0, 1), cA + hstep, voffA);
        if (wr == 1) PG8_BAR;
        PG8_WAIT_V(4); PG8_BAR;
        PG8_STAGE(PG8_SB(1, 0), cB + kstep, voffB); PG8_STAGE(PG8_SA(1, 0), cA + kstep, voffA); PG8_STAGE(PG8_SB(1, 1), cB + hstep + kstep, voffB);
        PG8_WAIT_V(6); PG8_BAR;
    }
    for (;;) {
        const bool has_next = S.next(ui + 1, nxt);
        const char* nA = has_next ? (const char*)g.A + (size_t)nxt.pm * tstep : cA; const char* nB = has_next ? (const char*)g.Bt + (size_t)nxt.pn * tstep : cB;
        for (int t = 0; t < nt; t += 2) {
            const bool last = (t == nt - 2);
            const char* a1 = cA + (size_t)(t + 1) * kstep;
            const char* a2 = last ? nA : cA + (size_t)(t + 2) * kstep; const char* b2 = last ? nB : cB + (size_t)(t + 2) * kstep;
            const char* a3 = a2 + kstep; const char* b3 = b2 + kstep;
            if (last && has_next) S.a_ready(nxt);
            if constexpr (SP2) {
            PG8_LDB(B0, 0, 0); PG8_LDB(B1, 0, 1); PG8_SCHED; PG8_LDA(At, 0, 0); PG8_STAGE(PG8_SA(1, 1), a1 + hstep, voffA);
            PG8_WAIT_V(8); PG8_WAIT_L(0); PG8_BAR; PG8_MMA(0, 0, At, B0); PG8_MMA(0, 1, At, B1); PG8_BAR; PG8_SCHED;
            PG8_LDA(At, 0, 1); PG8_STAGE(PG8_SB(0, 0), b2, voffB); PG8_STAGE(PG8_SB(0, 1), b2 + hstep, voffB); PG8_STAGE(PG8_SA(0, 0), a2, voffA);
            PG8_WAIT_V(8); PG8_WAIT_L(0); PG8_BAR; PG8_MMA(1, 0, At, B0); PG8_MMA(1, 1, At, B1); PG8_BAR; PG8_SCHED;
            PG8_LDB(B0, 1, 0); PG8_LDB(B1, 1, 1); PG8_SCHED; PG8_LDA(At, 1, 0); PG8_STAGE(PG8_SA(0, 1), a2 + hstep, voffA);
            PG8_WAIT_V(8); PG8_WAIT_L(0); PG8_BAR; PG8_MMA(0, 0, At, B0); PG8_MMA(0, 1, At, B1); PG8_BAR; PG8_SCHED;
            PG8_LDA(At, 1, 1); PG8_STAGE(PG8_SB(1, 0), b3, voffB); PG8_STAGE(PG8_SB(1, 1), b3 + hstep, voffB); PG8_STAGE(PG8_SA(1, 0), a3, voffA);
            PG8_WAIT_V(8); PG8_WAIT_L(0); PG8_BAR; PG8_MMA(1, 0, At, B0); PG8_MMA(1, 1, At, B1); PG8_BAR; PG8_SCHED;
            } else {
            PG8_LDB(B0, 0, 0); PG8_SCHED; PG8_LDA(At, 0, 0); PG8_STAGE(PG8_SA(1, 1), a1 + hstep, voffA);
            PG8_WAIT_L(8); PG8_BAR; PG8_WAIT_L(0); PG8_MMA(0, 0, At, B0); PG8_BAR; PG8_SCHED;
            PG8_LDB(B1, 0, 1); PG8_STAGE(PG8_SB(0, 0), b2, voffB);
            PG8_BAR; PG8_WAIT_L(0); PG8_MMA(0, 1, At, B1); PG8_BAR;
            PG8_LDA(At, 0, 1); PG8_STAGE(PG8_SA(0, 0), a2, voffA);
            PG8_BAR; PG8_WAIT_L(0); PG8_MMA(1, 0, At, B0); PG8_BAR; PG8_SCHED;
            PG8_STAGE(PG8_SB(0, 1), b2 + hstep, voffB);
            PG8_WAIT_V(6); PG8_BAR; PG8_MMA(1, 1, At, B1); PG8_BAR;
            PG8_LDB(B0, 1, 0); PG8_SCHED; PG8_LDA(At, 1, 0); PG8_STAGE(PG8_SA(0, 1), a2 + hstep, voffA);
            PG8_WAIT_L(8); PG8_BAR; PG8_WAIT_L(0); PG8_MMA(0, 0, At, B0); PG8_BAR; PG8_SCHED;
            PG8_LDB(B1, 1, 1); PG8_STAGE(PG8_SB(1, 0), b3, voffB);
            PG8_BAR; PG8_WAIT_L(0); PG8_MMA(0, 1, At, B1); PG8_BAR;
            PG8_LDA(At, 1, 1); PG8_STAGE(PG8_SA(1, 0), a3, voffA);
            PG8_BAR; PG8_WAIT_L(0); PG8_MMA(1, 0, At, B0); PG8_BAR; PG8_SCHED;
            PG8_STAGE(PG8_SB(1, 1), b3 + hstep, voffB);
            PG8_WAIT_V(6); PG8_BAR; PG8_MMA(1, 1, At, B1); PG8_BAR;
            }
        }
        if constexpr (ALIGN_EPI) { if (wr == 0) PG8_BAR; }
        if constexpr (!Epi::AFTER_DRAIN) { E(acc, cur, wr, wc, fr, fq); S.done(cur); }
        if (!has_next) break;
#pragma unroll
        for (int a = 0; a < 2; ++a)
#pragma unroll
            for (int b = 0; b < 2; ++b)
#pragma unroll
                for (int m = 0; m < 4; ++m)
#pragma unroll
                    for (int n = 0; n < 2; ++n) acc[a][b][m][n] = (f32x4){0.f, 0.f, 0.f, 0.f};
        cur = nxt; cA = nA; cB = nB; ++ui;
        if constexpr (ALIGN_EPI) { if (wr == 1) PG8_BAR; }
    }
    PG8_WAIT_V(0);
    if constexpr (!ALIGN_EPI) { if (wr == 0) PG8_BAR; }
    PG8_BAR;
    if constexpr (Epi::AFTER_DRAIN) { E.fused(acc, cur, wr, wc, fr, fq, lds, wid, lane); S.done(cur); }
#undef PG8_SA
#undef PG8_SB
#undef PG8_STAGE
#undef PG8_LDA
#undef PG8_LDB
#undef PG8_MMA
#undef PG8_WAIT_V
#undef PG8_WAIT_L
#undef PG8_BAR
#undef PG8_SCHED
}
}

#ifndef PG8_SP2
#define PG8_SP2 true
#endif
#ifndef PG8_ALIGN
#define PG8_ALIGN true
#endif

constexpr int NWAVES = 8;
constexpr int BATCH = 8, SEQ = 4096, D = 1024, DFF = 2816, MTOK = BATCH * SEQ;
constexpr int MH = MTOK / 2;
constexpr int MEML = 256, MEMROWS = BATCH * MEML;
constexpr int INCOLS = 6144;
constexpr size_t MiB = 1u << 20;
constexpr size_t WS_CTL = 0, CTL_ZERO_BYTES = 1 * MiB;
constexpr size_t WS_W1A = 2 * MiB, WS_W2A = 13 * MiB, WS_W1B = 19 * MiB, WS_W2B = 30 * MiB, WS_WIN = 36 * MiB, WS_WKV = 48 * MiB, WS_WBR = 50 * MiB, WS_WOUT = 53 * MiB;
constexpr size_t WS_MEMN = 55 * MiB, WS_KVM = 59 * MiB, WS_COS = 63 * MiB, WS_SIN = 64 * MiB;
constexpr size_t WS_XN = 66 * MiB;
constexpr size_t WS_X = 130 * MiB;
constexpr size_t WS_R = 322 * MiB;
constexpr size_t WS_Y = 462 * MiB;
constexpr size_t WS_END = 510 * MiB;
constexpr size_t XO_PRW = 0, XO_QS = 56 * MiB, XO_KVS = 72 * MiB, XO_QM = 80 * MiB, XO_GT = 96 * MiB;
constexpr int CW_BAR = 4096;

constexpr int RING_OFF = 0, RING_BYTES = 131072;
constexpr int LDSCTL_OFF = RING_BYTES, MISC_OFF = LDSCTL_OFF + 320;
constexpr int LDS_BYTES = 147456;
#define GAS __attribute__((address_space(1)))
#define LAS __attribute__((address_space(3)))
typedef unsigned short bf16;
typedef unsigned v4u __attribute__((ext_vector_type(4)));
typedef float f32x4 __attribute__((ext_vector_type(4)));
typedef short bf16x8 __attribute__((ext_vector_type(8)));
typedef GAS unsigned gu32;
typedef GAS unsigned long long gu64;
#define RLX_AGENT __ATOMIC_RELAXED, __HIP_MEMORY_SCOPE_AGENT
#define LDS_WAIT() asm volatile("s_waitcnt lgkmcnt(0)" ::: "memory")
#define VM_WAIT() asm volatile("s_waitcnt vmcnt(0)" ::: "memory")
__device__ __forceinline__ unsigned long long rt() { return __builtin_amdgcn_s_memrealtime(); }
__device__ __forceinline__ unsigned f2bf(float f) { unsigned u = __builtin_bit_cast(unsigned, f); return (u + 0x7fffu + ((u >> 16) & 1u)) >> 16; }
__device__ __forceinline__ unsigned pk2(float lo, float hi) { return f2bf(lo) | (f2bf(hi) << 16); }

#define XB_TMO      128
#define XB_XCNT(j)  (256  + 64 * (j))
#define XB_XSUB(j)  (1280 + 64 * (j))
#define XB_XGEN(j)  (2304 + 64 * (j))
#define XB_TOP      3328
#define XB_TOPGEN   3392
#define XCD_BAR_WORDS 3456
#define XB_SPIN_CAP (1u << 18)

__device__ __forceinline__ unsigned xb_ld(unsigned* p)              { return __hip_atomic_load(p, __ATOMIC_RELAXED, __HIP_MEMORY_SCOPE_AGENT); }
__device__ __forceinline__ unsigned xb_add(unsigned* p, unsigned v) { return __hip_atomic_fetch_add(p, v, __ATOMIC_RELAXED, __HIP_MEMORY_SCOPE_AGENT); }
__device__ __forceinline__ unsigned xb_xcc_id() { return (unsigned)__builtin_amdgcn_s_getreg((3 << 11) | 20) & 0xFu; }
#define XB_SPIN(cond, bar) do { unsigned _sp = 0; while (cond) { __builtin_amdgcn_s_sleep(1); \
    if ((++_sp & 255u) == 0u) { if (xb_ld(&(bar)[XB_TMO])) break; if (_sp > XB_SPIN_CAP) { atomicAdd(&(bar)[XB_TMO], 1u); break; } } } } while (0)

struct XcdBarrier {
    unsigned* bar; unsigned x;
    volatile LAS unsigned* st;
};

__device__ __forceinline__ XcdBarrier xcd_barrier_post(unsigned* bar, volatile LAS unsigned* st) {
    XcdBarrier b; b.bar = bar; b.x = xb_xcc_id(); b.st = st;
    if (threadIdx.x == 0) (void)xb_add(&bar[XB_XCNT(b.x)], 1u);
    return b;
}
__device__ __forceinline__ void xcd_barrier_complete(unsigned* bar, unsigned x, unsigned& nloc, unsigned& nx) {
    const unsigned G = gridDim.x * gridDim.y * gridDim.z;
    unsigned sum, cnt, mine, sp = 0u;
    for (;;) {
        sum = 0u; cnt = 0u; mine = 0u;
#pragma unroll
        for (unsigned j = 0; j < 16; ++j) { const unsigned c = xb_ld(&bar[XB_XCNT(j)]); sum += c; cnt += (c > 0u) ? 1u : 0u; mine = (j == x) ? c : mine; }
        if (sum == G) break;
        __builtin_amdgcn_s_sleep(1);
        if ((++sp & 255u) == 0u) { if (xb_ld(&bar[XB_TMO])) break; if (sp > XB_SPIN_CAP) { atomicAdd(&bar[XB_TMO], 1u); break; } }
    }
    nloc = mine > 0u ? mine : 1u; nx = cnt > 0u ? cnt : 1u;
}

__device__ __forceinline__ void xcd_barrier(const XcdBarrier& b) {
    asm volatile("s_waitcnt vmcnt(0)" ::: "memory");
    __syncthreads();
    if (threadIdx.x == 0) {
        unsigned* bar = b.bar;
        __builtin_amdgcn_s_waitcnt(0);
        unsigned nloc = b.st[0], nx = b.st[1];
        if (nloc == 0u) { xcd_barrier_complete(bar, b.x, nloc, nx); b.st[0] = nloc; b.st[1] = nx; }
        const unsigned old = xb_add(&bar[XB_XSUB(b.x)], 1u);
        const unsigned gen = old / nloc;
        if (old + 1u == (gen + 1u) * nloc) {
            __builtin_amdgcn_fence(__ATOMIC_RELEASE, "agent");
            asm volatile("s_waitcnt vmcnt(0)" ::: "memory");
            const unsigned og = xb_add(&bar[XB_TOP], 1u);
            const unsigned tg = og / nx;
            if (og + 1u == (tg + 1u) * nx) xb_add(&bar[XB_TOPGEN], 1u);
            else XB_SPIN(xb_ld(&bar[XB_TOPGEN]) == tg, bar);
            __builtin_amdgcn_fence(__ATOMIC_ACQUIRE, "agent");
            xb_add(&bar[XB_XGEN(b.x)], 1u);
            asm volatile("s_waitcnt vmcnt(0)" ::: "memory");
        } else {
            XB_SPIN(xb_ld(&bar[XB_XGEN(b.x)]) == gen, bar);
            __builtin_amdgcn_fence(__ATOMIC_ACQUIRE, "agent");
            asm volatile("s_waitcnt vmcnt(0)" ::: "memory");
        }
    }
    __syncthreads();
}

struct Frame {
    LAS unsigned char* lds;
    volatile LAS unsigned* MISC;
    gu32* ctl;
    int tid, lane, wave;
    int vcu, G;
};
__device__ __forceinline__ float wave_sum(float v) {
#pragma unroll
    for (int o = 1; o < 64; o <<= 1) v += __shfl_xor(v, o);
    return v;
}
__device__ __forceinline__ float bf2f(bf16 v) { return __uint_as_float(((unsigned)v) << 16); }
__device__ __forceinline__ float sigm(float x) { return 1.0f / (1.0f + __expf(-x)); }

__device__ __forceinline__ void p0_transpose_item(const float* W, int K, int N, bf16* WT, int k0, int n0, int drow0, LAS float* scr, int lane) {
#pragma unroll 8
    for (int i = 0; i < 32; ++i) { const int kk = 2 * i + (lane >> 5); scr[kk * 33 + (lane & 31)] = W[(size_t)(k0 + kk) * N + n0 + (lane & 31)]; }
    LDS_WAIT(); asm volatile("" ::: "memory");
    const int c = lane & 7;
#pragma unroll
    for (int j = 0; j < 4; ++j) { const int n = (lane >> 3) + 8 * j; const LAS float* s = scr + (8 * c) * 33 + n;
        v4u o; o.x = pk2(s[0 * 33], s[1 * 33]); o.y = pk2(s[2 * 33], s[3 * 33]); o.z = pk2(s[4 * 33], s[5 * 33]); o.w = pk2(s[6 * 33], s[7 * 33]);
        *(GAS v4u*)(WT + (size_t)(drow0 + n) * K + k0 + 8 * c) = o; }
    LDS_WAIT(); asm volatile("" ::: "memory");
}
template <bool SWIGLU>
__device__ __forceinline__ void p0_transpose(const float* W, int K, int N, bf16* WT, LAS float* scr, int gw, int NGW, int lane) {
    const int nblk = N / 32, nitems = (K / 64) * nblk;
    for (int it = gw; it < nitems; it += NGW) {
        const int kb = it / nblk, nb = it % nblk, n0 = 32 * nb; int drow0 = n0;
        if (SWIGLU) { const int up = n0 >= DFF, j = up ? n0 - DFF : n0; drow0 = 256 * (j / 128) + 128 * up + (j % 128); }
        p0_transpose_item(W, K, N, WT, 64 * kb, n0, drow0, scr, lane);
    }
}
__device__ __forceinline__ void rms_row_to_bf16(const float* xrow, const float* g, bf16* orow, int lane) {
    const GAS f32x4* xr = (const GAS f32x4*)xrow + lane; const GAS f32x4* gr = (const GAS f32x4*)g + lane;
    f32x4 v[4]; float s = 0.f;
#pragma unroll
    for (int j = 0; j < 4; ++j) { v[j] = xr[64 * j]; s += (v[j].x * v[j].x + v[j].y * v[j].y) + (v[j].z * v[j].z + v[j].w * v[j].w); }
    const float r = 1.0f / sqrtf(wave_sum(s) * (1.f / D) + 1e-6f);
    GAS unsigned long long* o8 = (GAS unsigned long long*)orow + lane;
#pragma unroll
    for (int j = 0; j < 4; ++j) { const f32x4 gg = gr[64 * j]; o8[64 * j] = (unsigned long long)pk2(v[j].x * r * gg.x, v[j].y * r * gg.y) | ((unsigned long long)pk2(v[j].z * r * gg.z, v[j].w * r * gg.w) << 32); }
}
__device__ __forceinline__ void norm_res_row(const float* Frow, const float* base, float alpha, const float* g1, float* hout, const float* g2, bf16* xn, int lane) {
    const GAS f32x4* fr = (const GAS f32x4*)Frow + lane; const GAS f32x4* br = (const GAS f32x4*)base + lane; const GAS f32x4* g1r = (const GAS f32x4*)g1 + lane;
    f32x4 v[4], b[4]; float s = 0.f;
#pragma unroll
    for (int j = 0; j < 4; ++j) { v[j] = fr[64 * j]; b[j] = br[64 * j]; s += (v[j].x * v[j].x + v[j].y * v[j].y) + (v[j].z * v[j].z + v[j].w * v[j].w); }
    const float r = alpha / sqrtf(wave_sum(s) * (1.f / D) + 1e-6f); float s2 = 0.f;
#pragma unroll
    for (int j = 0; j < 4; ++j) { const f32x4 gg = g1r[64 * j]; v[j] = b[j] + v[j] * r * gg; s2 += (v[j].x * v[j].x + v[j].y * v[j].y) + (v[j].z * v[j].z + v[j].w * v[j].w); }
    GAS f32x4* ho = (GAS f32x4*)hout + lane;
#pragma unroll
    for (int j = 0; j < 4; ++j) ho[64 * j] = v[j];
    if (xn) {
        const float r2 = 1.0f / sqrtf(wave_sum(s2) * (1.f / D) + 1e-6f); const GAS f32x4* g2r = (const GAS f32x4*)g2 + lane;
        GAS unsigned long long* o8 = (GAS unsigned long long*)xn + lane;
#pragma unroll
        for (int j = 0; j < 4; ++j) { const f32x4 gg = g2r[64 * j]; o8[64 * j] = (unsigned long long)pk2(v[j].x * r2 * gg.x, v[j].y * r2 * gg.y) | ((unsigned long long)pk2(v[j].z * r2 * gg.z, v[j].w * r2 * gg.w) << 32); }
    }
}

struct MixIn {
    const bf16 *Prw, *Qs, *KVs, *Qm, *KVm; const float *cosT, *sinT;
    const float *mu, *w0, *w_up, *a0, *a_up, *g_up, *k_k, *k_a, *r_k, *gn_g, *gn_b, *sinks;
    bf16 *Ya, *Yb, *Yc; int half;
};
__device__ __forceinline__ float rl(float v, int k) { return __uint_as_float((unsigned)__builtin_amdgcn_readlane((int)__float_as_uint(v), k)); }
__device__ __forceinline__ void rwkv_naive_wave(const MixIn& X, int bh, int lane) {
    const int bl = bh >> 3, h = bh & 7, hj = h * 64 + lane;
    const float mu_r = X.mu[hj], mu_k = X.mu[512 + hj], mu_v = X.mu[1024 + hj], mu_w = X.mu[1536 + lane], mu_a = X.mu[1600 + lane], mu_g0 = X.mu[1664 + lane], mu_g1 = X.mu[1728 + lane];
    const float w0 = X.w0[hj], a0 = X.a0[hj], k_k = X.k_k[hj], k_a = X.k_a[hj], r_k = X.r_k[hj], gn_g = X.gn_g[hj], gn_b = X.gn_b[hj];
    float pr = 0.f, pk = 0.f, pv = 0.f, pw = 0.f, pa = 0.f, pg0 = 0.f, pg1 = 0.f;
    float S[64];
#pragma unroll
    for (int k = 0; k < 64; ++k) S[k] = 0.f;
    for (int t = 0; t < SEQ; ++t) {
        const size_t row = (size_t)bl * SEQ + t; const bf16* P = X.Prw + row * 1792;
        const float cr = bf2f(P[hj]), ck = bf2f(P[512 + hj]), cv = bf2f(P[1024 + hj]), cw = bf2f(P[1536 + lane]), ca = bf2f(P[1600 + lane]), cg0 = bf2f(P[1664 + lane]), cg1 = bf2f(P[1728 + lane]);
        const float xr = cr + (pr - cr) * mu_r, xk = ck + (pk - ck) * mu_k, xv = cv + (pv - cv) * mu_v, xw = cw + (pw - cw) * mu_w, xa = ca + (pa - ca) * mu_a, xg0 = cg0 + (pg0 - cg0) * mu_g0, xg1 = cg1 + (pg1 - cg1) * mu_g1;
        pr = cr; pk = ck; pv = cv; pw = cw; pa = ca; pg0 = cg0; pg1 = cg1;
        const float tw = tanhf(xw), s0 = sigm(xg0), s1 = sigm(xg1);
        float lw = w0, la = a0, lg = 0.f;
        for (int i = 0; i < 64; ++i) {
            lw += __shfl(tw, i) * X.w_up[i * 512 + hj];
            la += __shfl(xa, i) * X.a_up[i * 512 + hj];
            lg += __shfl(s0, i) * X.g_up[i * 512 + hj] + __shfl(s1, i) * X.g_up[(64 + i) * 512 + hj];
        }
        const float decay = __expf(-0.6065306597126334f * sigm(lw));
        const float asig = sigm(la);
        const float kkj = xk * k_k; const float nrm = sqrtf(wave_sum(kkj * kkj)); const float kk = kkj / fmaxf(nrm, 1e-12f);
        const float kt = xk * (1.0f + (asig - 1.0f) * k_a);
        const float av = -kk, bv = kk * asig;
        const float bonus = wave_sum(xr * kt * r_k);
        float sa = 0.f;
#pragma unroll
        for (int k = 0; k < 64; ++k) sa += S[k] * rl(av, k);
        float y = 0.f;
#pragma unroll
        for (int k = 0; k < 64; ++k) { S[k] = S[k] * rl(decay, k) + sa * rl(bv, k) + xv * rl(kt, k); y += S[k] * rl(xr, k); }
        const float mean = wave_sum(y) * (1.f / 64.f); const float d = y - mean; const float var = wave_sum(d * d) * (1.f / 64.f);
        float yn = d * (1.0f / sqrtf(var + 64e-5f)) * gn_g + gn_b;
        yn += bonus * xv;
        X.Ya[row * 512 + hj] = (bf16)f2bf(yn * lg);
    }
}
__device__ __forceinline__ void swa_naive_item(const MixIn& X, int m, int hq, int lane) {
    const int t = m & (SEQ - 1), hkv = hq >> 2; const size_t grow = (size_t)X.half * MH + m;
    float q = bf2f(X.Qs[(size_t)m * 512 + hq * 64 + lane]);
    { const float partner = __shfl(q, lane < 8 ? lane + 8 : (lane < 16 ? lane - 8 : lane)); const float c = X.cosT[grow * 8 + (lane & 7)], s = X.sinT[grow * 8 + (lane & 7)];
      if (lane < 8) q = q * c - partner * s; else if (lane < 16) q = q * c + partner * s; }
    q *= 0.125f;
    float mx = X.sinks[hq], l = 1.0f, o = 0.f;
    const int j0 = t >= 127 ? t - 127 : 0;
    for (int j = j0; j <= t; ++j) {
        const size_t kr = (size_t)(m - t + j), gk = grow - t + j;
        float kx = bf2f(X.KVs[kr * 256 + hkv * 64 + lane]); const float vx = bf2f(X.KVs[kr * 256 + 128 + hkv * 64 + lane]);
        { const float partner = __shfl(kx, lane < 8 ? lane + 8 : (lane < 16 ? lane - 8 : lane)); const float c = X.cosT[gk * 8 + (lane & 7)], s = X.sinT[gk * 8 + (lane & 7)];
          if (lane < 8) kx = kx * c - partner * s; else if (lane < 16) kx = kx * c + partner * s; }
        const float sc = wave_sum(q * kx);
        const float mn = fmaxf(mx, sc), f = __expf(mx - mn), p = __expf(sc - mn);
        l = l * f + p; o = o * f + p * vx; mx = mn;
    }
    X.Yb[(size_t)m * 512 + hq * 64 + lane] = (bf16)f2bf(o / l);
}
__device__ __forceinline__ void mem_naive_item(const MixIn& X, int m, int h, int lane) {
    const int bg = X.half * (BATCH / 2) + (m >> 12);
    const float sc0 = 0.08838834764831845f;
    const float q0 = bf2f(X.Qm[(size_t)m * 512 + h * 128 + lane]) * sc0, q1 = bf2f(X.Qm[(size_t)m * 512 + h * 128 + 64 + lane]) * sc0;
    float mx = -1e30f, l = 0.f, o0 = 0.f, o1 = 0.f;
    for (int j = 0; j < MEML; ++j) {
        const bf16* kv = X.KVm + (size_t)(bg * MEML + j) * 1024;
        const float sc = wave_sum(q0 * bf2f(kv[h * 128 + lane]) + q1 * bf2f(kv[h * 128 + 64 + lane]));
        const float mn = fmaxf(mx, sc), f = __expf(mx - mn), p = __expf(sc - mn);
        l = l * f + p; o0 = o0 * f + p * bf2f(kv[512 + h * 128 + lane]); o1 = o1 * f + p * bf2f(kv[512 + h * 128 + 64 + lane]); mx = mn;
    }
    X.Yc[(size_t)m * 512 + h * 128 + lane] = (bf16)f2bf(o0 / l); X.Yc[(size_t)m * 512 + h * 128 + 64 + lane] = (bf16)f2bf(o1 / l);
}


struct Args { const void* in[31]; float* out; unsigned char* ws; int ph_lo, ph_hi; };
constexpr int NPH = 17;
typedef __attribute__((address_space(4))) const unsigned char* kptr_t;
struct KA { kptr_t p;
    __device__ __forceinline__ const void* operator[](int i) const { return *(const void* const __attribute__((address_space(4)))*)(p + 8 * i); } };
struct ArgsView { KA in; float* out; unsigned char* ws; };
__device__ __forceinline__ ArgsView args_view() {
    kptr_t p = (kptr_t)__builtin_amdgcn_kernarg_segment_ptr(); asm volatile("" : "+s"(p));
    ArgsView a; a.in.p = p; a.out = (float*)a.in[31]; a.ws = (unsigned char*)a.in[32]; return a; }
extern __shared__ __attribute__((aligned(16))) unsigned char lds_dyn[];
__device__ __forceinline__ void frame_fill(Frame& F, const ArgsView& args) {
    F.lds = (LAS unsigned char*)lds_dyn;
    F.MISC = (volatile LAS unsigned*)(F.lds + MISC_OFF);
    { int t_ = threadIdx.x; asm volatile("" : "+v"(t_)); F.tid = t_; } F.lane = F.tid & 63; F.wave = __builtin_amdgcn_readfirstlane(F.tid >> 6);
    F.G = gridDim.x; { int bx = blockIdx.x; asm volatile("" : "+s"(bx)); F.vcu = (F.G % 8 == 0) ? (bx % 8) * (F.G / 8) + bx / 8 : bx; }
    F.ctl = (gu32*)(args.ws + WS_CTL);
}
__device__ __forceinline__ XcdBarrier bar_view() {
    const ArgsView args = args_view();
    XcdBarrier b; b.bar = (unsigned*)((gu32*)(args.ws + WS_CTL) + CW_BAR); b.x = xb_xcc_id(); b.st = (volatile LAS unsigned*)((LAS unsigned char*)lds_dyn + MISC_OFF) + 8; return b;
}
template <int PH>
__device__ __forceinline__ void run_phase() {
    const ArgsView args = args_view();
    Frame F; frame_fill(F, args);
    unsigned char* ws = args.ws;
    float* out = args.out;
    bf16* XN = (bf16*)(ws + WS_XN); bf16* HB = (bf16*)(ws + WS_X); float* FB = (float*)(ws + WS_R);
    bf16* PRW = (bf16*)(ws + WS_X + XO_PRW); bf16* QS = (bf16*)(ws + WS_X + XO_QS); bf16* KVS = (bf16*)(ws + WS_X + XO_KVS); bf16* QM = (bf16*)(ws + WS_X + XO_QM); bf16* GT = (bf16*)(ws + WS_X + XO_GT);
    bf16* MERGED = (bf16*)(ws + WS_R); float* FH = (float*)(ws + WS_R + 32 * MiB);
    bf16* YA = (bf16*)(ws + WS_Y); bf16* YB = (bf16*)(ws + WS_Y + 16 * MiB); bf16* YC = (bf16*)(ws + WS_Y + 32 * MiB);
    bf16* WBR = (bf16*)(ws + WS_WBR); bf16* KVM = (bf16*)(ws + WS_KVM);
    const int gw = F.vcu * NWAVES + F.wave, NGW = F.G * NWAVES;
    if constexpr (PH == 0) {
        const float* x = (const float*)args.in[0]; const float* mem = (const float*)args.in[1]; const int* positions = (const int*)args.in[2];
        bf16* MEMN = (bf16*)(ws + WS_MEMN); float* COS = (float*)(ws + WS_COS); float* SIN = (float*)(ws + WS_SIN);
        LAS float* scr = (LAS float*)(F.lds + RING_OFF + F.wave * 16384);
        p0_transpose<true>((const float*)args.in[4], D, 2 * DFF, (bf16*)(ws + WS_W1A), scr, gw, NGW, F.lane);
        p0_transpose<false>((const float*)args.in[5], DFF, D, (bf16*)(ws + WS_W2A), scr, gw, NGW, F.lane);
        p0_transpose<true>((const float*)args.in[28], D, 2 * DFF, (bf16*)(ws + WS_W1B), scr, gw, NGW, F.lane);
        p0_transpose<false>((const float*)args.in[29], DFF, D, (bf16*)(ws + WS_W2B), scr, gw, NGW, F.lane);
        p0_transpose<false>((const float*)args.in[8], D, INCOLS, (bf16*)(ws + WS_WIN), scr, gw, NGW, F.lane);
        p0_transpose<false>((const float*)args.in[23], D, D, (bf16*)(ws + WS_WKV), scr, gw, NGW, F.lane);
        for (int br = 0; br < 3; ++br) p0_transpose<false>((const float*)args.in[24] + (size_t)br * 512 * D, 512, D, WBR + (size_t)br * D * 512, scr, gw, NGW, F.lane);
        p0_transpose<false>((const float*)args.in[25], D, D, (bf16*)(ws + WS_WOUT), scr, gw, NGW, F.lane);
        for (int m = gw; m < MTOK; m += NGW) rms_row_to_bf16(x + (size_t)m * D, (const float*)args.in[3], XN + (size_t)m * D, F.lane);
        for (int m = gw; m < MEMROWS; m += NGW) rms_row_to_bf16(mem + (size_t)m * D, (const float*)args.in[22], MEMN + (size_t)m * D, F.lane);
        for (int i = blockIdx.x * (NWAVES * 64) + F.tid; i < MTOK * 8; i += F.G * NWAVES * 64) {
            const int tok = i >> 3, f = i & 7; const double inv = pow(500000.0, -(double)f / 8.0); const double ang = (double)positions[tok] * inv;
            COS[i] = (float)cos(ang); SIN[i] = (float)sin(ang); }
    } else if constexpr (PH == 1 || PH == 14) {
        pg8::Gemm g{XN, (const bf16*)(ws + (PH == 1 ? WS_W1A : WS_W1B)), MTOK, 2 * DFF, D}; pg8::StaticOrder S; S.init(MTOK, 2 * DFF, F.G, (int)blockIdx.x);
        pg8::EpiSwiglu E{HB, DFF};
        pg8::gemm_phase<pg8::EpiSwiglu, pg8::StaticOrder, PG8_ALIGN, PG8_SP2>(F.lds + RING_OFF, g, S, E);
        if constexpr (PH == 1) {
            pg8::Gemm g2{(const bf16*)(ws + WS_MEMN), (const bf16*)(ws + WS_WKV), MEMROWS, D, D}; pg8::StaticOrder S2; S2.init(MEMROWS, D, F.G, (int)blockIdx.x);
            pg8::EpiBf16Plain E2{KVM, D};
            pg8::gemm_phase<pg8::EpiBf16Plain, pg8::StaticOrder, PG8_ALIGN, PG8_SP2>(F.lds + RING_OFF, g2, S2, E2);
        }
    } else if constexpr (PH == 2 || PH == 15) {
        pg8::Gemm g{HB, (const bf16*)(ws + (PH == 2 ? WS_W2A : WS_W2B)), MTOK, D, DFF}; pg8::StaticOrder S; S.init(MTOK, D, F.G, (int)blockIdx.x);
        pg8::EpiF32 E{FB, D};
        pg8::gemm_phase<pg8::EpiF32, pg8::StaticOrder, PG8_ALIGN, PG8_SP2>(F.lds + RING_OFF, g, S, E);
    } else if constexpr (PH == 3) {
        const float* x = (const float*)args.in[0];
        for (int m = gw; m < MTOK; m += NGW) norm_res_row(FB + (size_t)m * D, x + (size_t)m * D, 0.5f, (const float*)args.in[6], out + (size_t)m * D, (const float*)args.in[7], XN + (size_t)m * D, F.lane);
    } else if constexpr (PH == 16) {
        for (int m = gw; m < MTOK; m += NGW) norm_res_row(FB + (size_t)m * D, out + (size_t)m * D, 0.5f, (const float*)args.in[30], out + (size_t)m * D, nullptr, nullptr, F.lane);
    } else {
        constexpr int hh = (PH - 4) / 5, sub = (PH - 4) % 5; constexpr size_t roff = (size_t)hh * MH;
        if constexpr (sub == 0) {
            pg8::Gemm g{XN + roff * D, (const bf16*)(ws + WS_WIN), MH, INCOLS, D}; pg8::StaticOrder S; S.init(MH, INCOLS, F.G, (int)blockIdx.x);
            pg8::EpiProj E{PRW, QS, KVS, QM, GT, (const float*)args.in[9]};
            pg8::gemm_phase<pg8::EpiProj, pg8::StaticOrder, PG8_ALIGN, PG8_SP2>(F.lds + RING_OFF, g, S, E);
        } else if constexpr (sub == 1) {
            MixIn X; X.Prw = PRW; X.Qs = QS; X.KVs = KVS; X.Qm = QM; X.KVm = KVM; X.cosT = (const float*)(ws + WS_COS); X.sinT = (const float*)(ws + WS_SIN);
            X.mu = (const float*)args.in[10]; X.w0 = (const float*)args.in[11]; X.w_up = (const float*)args.in[12]; X.a0 = (const float*)args.in[13]; X.a_up = (const float*)args.in[14]; X.g_up = (const float*)args.in[15];
            X.k_k = (const float*)args.in[16]; X.k_a = (const float*)args.in[17]; X.r_k = (const float*)args.in[18]; X.gn_g = (const float*)args.in[19]; X.gn_b = (const float*)args.in[20]; X.sinks = (const float*)args.in[21];
            X.Ya = YA; X.Yb = YB; X.Yc = YC; X.half = hh;
            const bool rw = (F.wave == 0 && F.vcu < 32);
            if (rw) rwkv_naive_wave(X, F.vcu, F.lane);
            else {
                const int aw = gw - (F.vcu < 32 ? F.vcu + 1 : 32), NAW = NGW - 32;
                for (int it = aw; it < MH * 8; it += NAW) swa_naive_item(X, it >> 3, it & 7, F.lane);
                for (int it = aw; it < MH * 4; it += NAW) mem_naive_item(X, it >> 2, it & 3, F.lane);
            }
        } else if constexpr (sub == 2) {
            for (int br = 0; br < 3; ++br) {
                pg8::Gemm g{br == 0 ? YA : (br == 1 ? YB : YC), WBR + (size_t)br * D * 512, MH, D, 512}; pg8::StaticOrder S; S.init(MH, D, F.G, (int)blockIdx.x);
                pg8::EpiMerge E{MERGED, GT, br * 1024, br == 0};
                pg8::gemm_phase<pg8::EpiMerge, pg8::StaticOrder, PG8_ALIGN, PG8_SP2>(F.lds + RING_OFF, g, S, E);
            }
        } else if constexpr (sub == 3) {
            pg8::Gemm g{MERGED, (const bf16*)(ws + WS_WOUT), MH, D, D}; pg8::StaticOrder S; S.init(MH, D, F.G, (int)blockIdx.x);
            pg8::EpiF32 E{FH, D};
            pg8::gemm_phase<pg8::EpiF32, pg8::StaticOrder, PG8_ALIGN, PG8_SP2>(F.lds + RING_OFF, g, S, E);
        } else {
            for (int m = gw; m < MH; m += NGW) norm_res_row(FH + (size_t)m * D, out + (roff + m) * D, 1.0f, (const float*)args.in[26], out + (roff + m) * D, (const float*)args.in[27], XN + (roff + m) * D, F.lane);
        }
    }
}
template <int PH>
__device__ __forceinline__ void run_from() {
    run_phase<PH>();
    if constexpr (PH + 1 < NPH) { xcd_barrier(bar_view()); run_from<PH + 1>(); }
}
__global__ void __launch_bounds__(NWAVES * 64, 2) fwd_all(Args args) {
    { LAS unsigned char* l = (LAS unsigned char*)lds_dyn;
      for (int u = threadIdx.x; u < (LDS_BYTES - LDSCTL_OFF) / 4; u += NWAVES * 64) ((LAS unsigned*)(l + LDSCTL_OFF))[u] = 0u;
      __syncthreads();
      const XcdBarrier b = bar_view(); (void)xcd_barrier_post(b.bar, b.st); }
    run_from<0>();
}

extern "C" void kernel_launch(void* const* d_in, const int* in_sizes, int n_in, void* d_out, int out_size, void* d_ws, size_t ws_size, hipStream_t stream) {
    static int grid = 0;
    if (grid == 0) {
        if (n_in != 31 || out_size != MTOK * D || ws_size < WS_END) { fprintf(stderr, "kernel_launch: unexpected shapes (n_in %d out %d ws %zu)\n", n_in, out_size, ws_size); grid = -1; return; }
        int dev = 0, cus = 0;
        if (hipGetDevice(&dev) != hipSuccess || hipDeviceGetAttribute(&cus, hipDeviceAttributeMultiprocessorCount, dev) != hipSuccess) { grid = -1; return; }
        if (hipFuncSetAttribute((const void*)fwd_all, hipFuncAttributeMaxDynamicSharedMemorySize, LDS_BYTES) != hipSuccess) { fprintf(stderr, "kernel_launch: hipFuncSetAttribute failed\n"); grid = -1; return; }
        (void)hipGetLastError();
        grid = cus;
    }
    if (grid < 0) return;
    (void)hipMemsetAsync((char*)d_ws + WS_CTL, 0, CTL_ZERO_BYTES, stream);
    Args a{};
    for (int i = 0; i < 31; ++i) a.in[i] = d_in[i];
    a.out = (float*)d_out; a.ws = (unsigned char*)d_ws; a.ph_lo = 0; a.ph_hi = NPH;
    hipLaunchKernelGGL(fwd_all, dim3(grid), dim3(NWAVES * 64), LDS_BYTES, stream, a);
}
```

```cpp
#include <hip/hip_runtime.h>
#include <cstdio>
#include <cstdint>
#include <cmath>
namespace pg8 {
#define PG8_LAS __attribute__((address_space(3)))
typedef unsigned short bf16_t;
typedef short bf16x8 __attribute__((ext_vector_type(8)));
typedef float f32x4 __attribute__((ext_vector_type(4)));
typedef unsigned u32x4 __attribute__((ext_vector_type(4)));
constexpr int BM = 256, BK = 64, HALF = 128, HTB = HALF * BK * 2  , STAGE_BYTES = 8 * HTB, NXCD = 8, WGM = 8;

__host__ __device__ __forceinline__ int lds_byte(int r, int c) { const int st = (r >> 4) * 2 + (c >> 5), rr = r & 15, cc = c & 31, ob = rr * 64 + cc * 2; return st * 1024 + (ob ^ (((ob >> 9) & 1) << 5)); }
__host__ __device__ __forceinline__ void stage_rc(int b, int& R, int& C) { const int st = b / 1024, sb = b % 1024, swz = sb ^ (((sb >> 9) & 1) << 5); R = (st >> 1) * 16 + swz / 64; C = (st & 1) * 32 + (swz % 64) / 2; }
__host__ __device__ __forceinline__ int perm32(int rho) { const int n = rho >> 4, i = rho & 15; return 8 * (i >> 2) + 4 * n + (i & 3); }

struct Unit { int pm, pn; };
struct Gemm { const bf16_t* A; const bf16_t* Bt; int M, N, K; };

struct StaticOrder {
    int nM, nN, nwg, G, c;
    __host__ __device__ void init(int M, int N, int G_, int c_) { nM = M / BM; nN = N / BM; nwg = nM * nN; G = G_; c = c_; }
    __host__ __device__ bool next(int i, Unit& u) const {
        const long L = (long)i * G + c; if (L >= nwg) return false;
        int wgid = (int)L; { const int q = nwg / NXCD, r = nwg % NXCD, xcd = wgid % NXCD, off = wgid / NXCD; wgid = (xcd < r ? xcd * (q + 1) : r * (q + 1) + (xcd - r) * q) + off; }
        const int nig = WGM * nN, gid = wgid / nig, fm = gid * WGM, gsz = (nM - fm) < WGM ? (nM - fm) : WGM;
        u.pm = fm + ((wgid % nig) % gsz); u.pn = (wgid % nig) / gsz; return true;
    }
    __device__ __forceinline__ void a_ready(const Unit&) const {}
    __device__ __forceinline__ void done(const Unit&) const {}
};

__device__ __forceinline__ unsigned cvt_pk_bf16(float lo, float hi) { unsigned r; asm volatile("v_cvt_pk_bf16_f32 %0, %1, %2" : "=v"(r) : "v"(lo), "v"(hi)); return r; }
typedef float f32x2 __attribute__((ext_vector_type(2)));
__device__ __forceinline__ float sigmoidf_(float x) { return 1.0f / (1.0f + __expf(-x)); }
__device__ __forceinline__ float bf2f(bf16_t v) { return __uint_as_float(((unsigned)v) << 16); }
struct EpiSwiglu {
    static constexpr bool PERM = true, AFTER_DRAIN = false;
    bf16_t* O; int ldc;
    __device__ __forceinline__ void operator()(const f32x4 (&acc)[2][2][4][2], const Unit& u, int wr, int wc, int fr, int fq) const {
        const int row0 = u.pm * BM + wr * 64 + fr, col0 = u.pn * HALF + wc * 32 + 8 * fq;
#pragma unroll
        for (int ai = 0; ai < 2; ++ai)
#pragma unroll
            for (int m = 0; m < 4; ++m) { bf16_t* rowp = O + (size_t)(row0 + ai * HALF + m * 16) * ldc + col0;
                float o[8];
#pragma unroll
                for (int n = 0; n < 2; ++n)
#pragma unroll
                    for (int i = 0; i < 4; ++i) { const float g = acc[ai][0][m][n][i], up = acc[ai][1][m][n][i]; o[4 * n + i] = g * sigmoidf_(g) * up; }
                u32x4 w; w.x = cvt_pk_bf16(o[0], o[1]); w.y = cvt_pk_bf16(o[2], o[3]); w.z = cvt_pk_bf16(o[4], o[5]); w.w = cvt_pk_bf16(o[6], o[7]);
                *(u32x4*)rowp = w; }
    }
};
struct EpiF32 {
    static constexpr bool PERM = false, AFTER_DRAIN = false;
    float* O; int ldc;
    __device__ __forceinline__ void operator()(const f32x4 (&acc)[2][2][4][2], const Unit& u, int wr, int wc, int fr, int fq) const {
        const int row0 = u.pm * BM + wr * 64 + fr, col0 = u.pn * BM + wc * 32 + 4 * fq;
#pragma unroll
        for (int ai = 0; ai < 2; ++ai)
#pragma unroll
            for (int m = 0; m < 4; ++m) { float* rowp = O + (size_t)(row0 + ai * HALF + m * 16) * ldc + col0;
#pragma unroll
                for (int bj = 0; bj < 2; ++bj)
#pragma unroll
                    for (int n = 0; n < 2; ++n) *(f32x4*)(rowp + bj * HALF + n * 16) = acc[ai][bj][m][n]; }
    }
};
struct EpiBf16Plain {
    static constexpr bool PERM = true, AFTER_DRAIN = false;
    bf16_t* O; int ldc;
    __device__ __forceinline__ void operator()(const f32x4 (&acc)[2][2][4][2], const Unit& u, int wr, int wc, int fr, int fq) const {
        const int row0 = u.pm * BM + wr * 64 + fr, col0 = u.pn * BM + wc * 32 + 8 * fq;
#pragma unroll
        for (int ai = 0; ai < 2; ++ai)
#pragma unroll
            for (int m = 0; m < 4; ++m) { bf16_t* rowp = O + (size_t)(row0 + ai * HALF + m * 16) * ldc + col0;
#pragma unroll
                for (int bj = 0; bj < 2; ++bj) { const f32x4 v0 = acc[ai][bj][m][0], v1 = acc[ai][bj][m][1];
                    u32x4 w; w.x = cvt_pk_bf16(v0[0], v0[1]); w.y = cvt_pk_bf16(v0[2], v0[3]); w.z = cvt_pk_bf16(v1[0], v1[1]); w.w = cvt_pk_bf16(v1[2], v1[3]);
                    *(u32x4*)(rowp + bj * HALF) = w; } }
    }
};
struct EpiProj {
    static constexpr bool PERM = true, AFTER_DRAIN = false;
    bf16_t *Prw, *Qs, *KVs, *Qm, *Gt; const float* gate_b;
    __device__ __forceinline__ void operator()(const f32x4 (&acc)[2][2][4][2], const Unit& u, int wr, int wc, int fr, int fq) const {
        bf16_t* base; int ldc, colt; const int pn = u.pn; bool gate = false;
        if (pn < 7) { base = Prw; ldc = 1792; colt = 256 * pn; }
        else if (pn < 9) { base = Qs; ldc = 512; colt = 256 * (pn - 7); }
        else if (pn < 10) { base = KVs; ldc = 256; colt = 0; }
        else if (pn < 12) { base = Qm; ldc = 512; colt = 256 * (pn - 10); }
        else { base = Gt; ldc = 3072; colt = 256 * (pn - 12); gate = true; }
        const int row0 = u.pm * BM + wr * 64 + fr, col0 = colt + wc * 32 + 8 * fq;
        f32x4 bv[2][2];
#pragma unroll
        for (int bj = 0; bj < 2; ++bj)
#pragma unroll
            for (int n = 0; n < 2; ++n) bv[bj][n] = gate ? *(const f32x4*)(gate_b + col0 + bj * HALF + 4 * n) : (f32x4){0.f, 0.f, 0.f, 0.f};
#pragma unroll
        for (int ai = 0; ai < 2; ++ai)
#pragma unroll
            for (int m = 0; m < 4; ++m) { bf16_t* rowp = base + (size_t)(row0 + ai * HALF + m * 16) * ldc + col0;
#pragma unroll
                for (int bj = 0; bj < 2; ++bj) { f32x4 v0 = acc[ai][bj][m][0] + bv[bj][0], v1 = acc[ai][bj][m][1] + bv[bj][1];
                    if (gate) {
#pragma unroll
                        for (int i = 0; i < 4; ++i) { v0[i] = sigmoidf_(v0[i]); v1[i] = sigmoidf_(v1[i]); } }
                    u32x4 w; w.x = cvt_pk_bf16(v0[0], v0[1]); w.y = cvt_pk_bf16(v0[2], v0[3]); w.z = cvt_pk_bf16(v1[0], v1[1]); w.w = cvt_pk_bf16(v1[2], v1[3]);
                    *(u32x4*)(rowp + bj * HALF) = w; } }
    }
};
struct EpiMerge {
    static constexpr bool PERM = true, AFTER_DRAIN = false;
    bf16_t* O; const bf16_t* G; int gcol; int first;
    __device__ __forceinline__ void operator()(const f32x4 (&acc)[2][2][4][2], const Unit& u, int wr, int wc, int fr, int fq) const {
        const int row0 = u.pm * BM + wr * 64 + fr, col0 = u.pn * BM + wc * 32 + 8 * fq;
#pragma unroll
        for (int ai = 0; ai < 2; ++ai)
#pragma unroll
            for (int m = 0; m < 4; ++m) { const size_t r = (size_t)(row0 + ai * HALF + m * 16);
#pragma unroll
                for (int bj = 0; bj < 2; ++bj) {
                    const u32x4 gw = *(const u32x4*)(G + r * 3072 + gcol + col0 + bj * HALF);
                    u32x4 ow = (u32x4){0u, 0u, 0u, 0u}; if (!first) ow = *(const u32x4*)(O + r * 1024 + col0 + bj * HALF);
                    float o[8];
#pragma unroll
                    for (int q = 0; q < 4; ++q) { const unsigned g2 = gw[q], o2 = ow[q];
                        const float a0 = acc[ai][bj][m][q >> 1][(q & 1) * 2], a1 = acc[ai][bj][m][q >> 1][(q & 1) * 2 + 1];
                        o[2 * q] = __uint_as_float(o2 << 16) + __uint_as_float(g2 << 16) * a0;
                        o[2 * q + 1] = __uint_as_float(o2 & 0xffff0000u) + __uint_as_float(g2 & 0xffff0000u) * a1; }
                    u32x4 w; w.x = cvt_pk_bf16(o[0], o[1]); w.y = cvt_pk_bf16(o[2], o[3]); w.z = cvt_pk_bf16(o[4], o[5]); w.w = cvt_pk_bf16(o[6], o[7]);
                    *(u32x4*)(O + r * 1024 + col0 + bj * HALF) = w; } }
    }
};
template <class Epi, class Sched, bool ALIGN_EPI = false, bool SP2 = false>
__device__ __forceinline__ void gemm_phase(PG8_LAS unsigned char* lds, const Gemm g, const Sched& S, const Epi& E) {
    int tid_ = threadIdx.x; asm volatile("" : "+v"(tid_));
    const int tid = tid_, wid = __builtin_amdgcn_readfirstlane(tid >> 6), lane = tid & 63, wr = wid >> 2, wc = wid & 3, fr = lane & 15, fq = lane >> 4;
    const int K = g.K, nt = K / BK;
    unsigned voffA[2], voffB[2];
#pragma unroll
    for (int i = 0; i < 2; ++i) { int R, C; stage_rc(tid * 16 + i * 8192, R, C); const int Rb = Epi::PERM ? ((R & ~31) + perm32(R & 31)) : R;
        voffA[i] = (unsigned)(R * K + C) * 2u; voffB[i] = (unsigned)(Rb * K + C) * 2u; }
    const size_t kstep = (size_t)(BK * 2);
    const size_t hstep = (size_t)HALF * K * 2;
    const size_t tstep = 2 * hstep;
    const unsigned ldsw = (unsigned)wid * 1024u;
    const int aoff = lds_byte(wr * 64 + fr, fq * 8), boff = lds_byte(wc * 32 + fr, fq * 8);
#define PG8_SA(b, h) (((b) * 2 + (h)) * HTB)
#define PG8_SB(b, h) ((4 + (b) * 2 + (h)) * HTB)
#define PG8_STAGE(bufoff, gbase, voff) do { _Pragma("unroll") for (int _i = 0; _i < 2; ++_i) \
        __builtin_amdgcn_global_load_lds((const unsigned*)((const char*)(gbase) + (voff)[_i]), (PG8_LAS unsigned*)(lds + (bufoff) + ldsw + _i * 8192), 16, 0, 0); } while (0)
#define PG8_LDA(dst, b, h) do { _Pragma("unroll") for (int m = 0; m < 4; ++m) _Pragma("unroll") for (int k = 0; k < 2; ++k) dst[m][k] = *(const PG8_LAS bf16x8*)(lds + PG8_SA(b, h) + aoff + m * 2048 + k * 1024); } while (0)
#define PG8_LDB(dst, b, h) do { _Pragma("unroll") for (int n = 0; n < 2; ++n) _Pragma("unroll") for (int k = 0; k < 2; ++k) dst[n][k] = *(const PG8_LAS bf16x8*)(lds + PG8_SB(b, h) + boff + n * 2048 + k * 1024); } while (0)
#define PG8_MMA(ai, bj, At, Bt) do { __builtin_amdgcn_s_setprio(1); _Pragma("unroll") for (int m = 0; m < 4; ++m) _Pragma("unroll") for (int n = 0; n < 2; ++n) _Pragma("unroll") for (int k = 0; k < 2; ++k) \
        acc[ai][bj][m][n] = __builtin_amdgcn_mfma_f32_16x16x32_bf16(Bt[n][k], At[m][k], acc[ai][bj][m][n], 0, 0, 0); __builtin_amdgcn_s_setprio(0); } while (0)
#define PG8_WAIT_V(n) asm volatile("s_waitcnt vmcnt(" #n ")" ::: "memory")
#define PG8_WAIT_L(n) asm volatile("s_waitcnt lgkmcnt(" #n ")" ::: "memory")
#define PG8_BAR __builtin_amdgcn_s_barrier()
#define PG8_SCHED __builtin_amdgcn_sched_barrier(0)
    Unit cur, nxt; int ui = 0;
    if (!S.next(0, cur)) return;
    f32x4 acc[2][2][4][2];
#pragma unroll
    for (int a = 0; a < 2; ++a)
#pragma unroll
        for (int b = 0; b < 2; ++b)
#pragma unroll
            for (int m = 0; m < 4; ++m)
#pragma unroll
                for (int n = 0; n < 2; ++n) acc[a][b][m][n] = (f32x4){0.f, 0.f, 0.f, 0.f};
    bf16x8 At[4][2], B0[2][2], B1[2][2];
    const char* cA = (const char*)g.A + (size_t)cur.pm * tstep; const char* cB = (const char*)g.Bt + (size_t)cur.pn * tstep;
    S.a_ready(cur);
    if constexpr (SP2) {
        PG8_STAGE(PG8_SB(0, 0), cB, voffB); PG8_STAGE(PG8_SB(0, 1), cB + hstep, voffB); PG8_STAGE(PG8_SA(0, 0), cA, voffA); PG8_STAGE(PG8_SA(0, 1), cA + hstep, voffA);
        if (wr == 1) PG8_BAR;
        PG8_WAIT_V(2); PG8_BAR;
        PG8_STAGE(PG8_SB(1, 0), cB + kstep, voffB); PG8_STAGE(PG8_SA(1, 0), cA + kstep, voffA); PG8_STAGE(PG8_SB(1, 1), cB + hstep + kstep, voffB);
        PG8_WAIT_V(6); PG8_BAR;
    } else {
        PG8_STAGE(PG8_SB(0, 0), cB, voffB); PG8_STAGE(PG8_SA(0, 0), cA, voffA); PG8_STAGE(PG8_SB(0, 1), cB + hstep, voffB); PG8_STAGE(PG8_SA(0, 1), cA + hstep, voffA);
        if (wr == 1) PG8_BAR;
        PG8_WAIT_V(4); PG8_BAR;
        PG8_STAGE(PG8_SB(1, 0), cB + kstep, voffB); PG8_STAGE(PG8_SA(1, 0), cA + kstep, voffA); PG8_STAGE(PG8_SB(1, 1), cB + hstep + kstep, voffB);
        PG8_WAIT_V(6); PG8_BAR;
    }
    for (;;) {
        const bool has_next = S.next(ui + 1, nxt);
        const char* nA = has_next ? (const char*)g.A + (size_t)nxt.pm * tstep : cA; const char* nB = has_next ? (const char*)g.Bt + (size_t)nxt.pn * tstep : cB;
        for (int t = 0; t < nt; t += 2) {
            const bool last = (t == nt - 2);
            const char* a1 = cA + (size_t)(t + 1) * kstep;
            const char* a2 = last ? nA : cA + (size_t)(t + 2) * kstep; const char* b2 = last ? nB : cB + (size_t)(t + 2) * kstep;
            const char* a3 = a2 + kstep; const char* b3 = b2 + kstep;
            if (last && has_next) S.a_ready(nxt);
            if constexpr (SP2) {
            PG8_LDB(B0, 0, 0); PG8_LDB(B1, 0, 1); PG8_SCHED; PG8_LDA(At, 0, 0); PG8_STAGE(PG8_SA(1, 1), a1 + hstep, voffA);
            PG8_WAIT_V(8); PG8_WAIT_L(0); PG8_BAR; PG8_MMA(0, 0, At, B0); PG8_MMA(0, 1, At, B1); PG8_BAR; PG8_SCHED;
            PG8_LDA(At, 0, 1); PG8_STAGE(PG8_SB(0, 0), b2, voffB); PG8_STAGE(PG8_SB(0, 1), b2 + hstep, voffB); PG8_STAGE(PG8_SA(0, 0), a2, voffA);
            PG8_WAIT_V(8); PG8_WAIT_L(0); PG8_BAR; PG8_MMA(1, 0, At, B0); PG8_MMA(1, 1, At, B1); PG8_BAR; PG8_SCHED;
            PG8_LDB(B0, 1, 0); PG8_LDB(B1, 1, 1); PG8_SCHED; PG8_LDA(At, 1, 0); PG8_STAGE(PG8_SA(0, 1), a2 + hstep, voffA);
            PG8_WAIT_V(8); PG8_WAIT_L(0); PG8_BAR; PG8_MMA(0, 0, At, B0); PG8_MMA(0, 1, At, B1); PG8_BAR; PG8_SCHED;
            PG8_LDA(At, 1, 1); PG8_STAGE(PG8_SB(1, 0), b3, voffB); PG8_STAGE(PG8_SB(1, 1), b3 + hstep, voffB); PG8_STAGE(PG8_SA(1, 0), a3, voffA);
            PG8_WAIT_V(8); PG8_WAIT_L(0); PG8_BAR; PG8_MMA(1, 0, At, B0); PG8_MMA(1, 1, At, B1); PG8_BAR; PG8_SCHED;
            } else {
            PG8_LDB(B0, 0, 0); PG8_SCHED; PG8_LDA(At, 0, 0); PG8_STAGE(PG8_SA(1, 1), a1 + hstep, voffA);
            PG8_WAIT_L(8); PG8_BAR; PG8_WAIT_L(0); PG8_MMA(0, 0, At, B0); PG8_BAR; PG8_SCHED;
            PG8_LDB(B1, 0, 1); PG8_STAGE(PG8_SB(0, 0), b2, voffB);
            PG8_BAR; PG8_WAIT_L(0); PG8_MMA(0, 1, At, B1); PG8_BAR;
            PG8_LDA(At, 0, 1); PG8_STAGE(PG8_SA(0, 0), a2, voffA);
            PG8_BAR; PG8_WAIT_L(0); PG8_MMA(1, 0, At, B0); PG8_BAR; PG8_SCHED;
            PG8_STAGE(PG8_SB(0, 1), b2 + hstep, voffB);
            PG8_WAIT_V(6); PG8_BAR; PG8_MMA(1, 1, At, B1); PG8_BAR;
            PG8_LDB(B0, 1, 0); PG8_SCHED; PG8_LDA(At, 1, 0); PG8_STAGE(PG8_SA(0, 1), a2 + hstep, voffA);
            PG8_WAIT_L(8); PG8_BAR; PG8_WAIT_L(0); PG8_MMA(0, 0, At, B0); PG8_BAR; PG8_SCHED;
            PG8_LDB(B1, 1, 1); PG8_STAGE(PG8_SB(1, 0), b3, voffB);
            PG8_BAR; PG8_WAIT_L(0); PG8_MMA(0, 1, At, B1); PG8_BAR;
            PG8_LDA(At, 1, 1); PG8_STAGE(PG8_SA(1, 0), a3, voffA);
            PG8_BAR; PG8_WAIT_L(0); PG8_MMA(1, 0, At, B0); PG8_BAR; PG8_SCHED;
            PG8_STAGE(PG8_SB(1, 1), b3 + hstep, voffB);
            PG8_WAIT_V(6); PG8_BAR; PG8_MMA(1, 1, At, B1); PG8_BAR;
            }
        }
        if constexpr (ALIGN_EPI) { if (wr == 0) PG8_BAR; }
        if constexpr (!Epi::AFTER_DRAIN) { E(acc, cur, wr, wc, fr, fq); S.done(cur); }
        if (!has_next) break;
#pragma unroll
        for (int a = 0; a < 2; ++a)
#pragma unroll
            for (int b = 0; b < 2; ++b)
#pragma unroll
                for (int m = 0; m < 4; ++m)
#pragma unroll
                    for (int n = 0; n < 2; ++n) acc[a][b][m][n] = (f32x4){0.f, 0.f, 0.f, 0.f};
        cur = nxt; cA = nA; cB = nB; ++ui;
        if constexpr (ALIGN_EPI) { if (wr == 1) PG8_BAR; }
    }
    PG8_WAIT_V(0);
    if constexpr (!ALIGN_EPI) { if (wr == 0) PG8_BAR; }
    PG8_BAR;
    if constexpr (Epi::AFTER_DRAIN) { E.fused(acc, cur, wr, wc, fr, fq, lds, wid, lane); S.done(cur); }
#undef PG8_SA
#undef PG8_SB
#undef PG8_STAGE
#undef PG8_LDA
#undef PG8_LDB
#undef PG8_MMA
#undef PG8_WAIT_V
#undef PG8_WAIT_L
#undef PG8_BAR
#undef PG8_SCHED
}
}

#ifndef PG8_SP2
#define PG8_SP2 true
#endif
#ifndef PG8_ALIGN
#define PG8_ALIGN true
#endif

constexpr int NWAVES = 8;
constexpr int BATCH = 8, SEQ = 4096, D = 1024, DFF = 2816, MTOK = BATCH * SEQ;
constexpr int MH = MTOK / 2;
constexpr int MEML = 256, MEMROWS = BATCH * MEML;
constexpr int INCOLS = 6144;
constexpr size_t MiB = 1u << 20;
constexpr size_t WS_CTL = 0, CTL_ZERO_BYTES = 1 * MiB;
constexpr size_t WS_W1A = 2 * MiB, WS_W2A = 13 * MiB, WS_W1B = 19 * MiB, WS_W2B = 30 * MiB, WS_WIN = 36 * MiB, WS_WKV = 48 * MiB, WS_WBR = 50 * MiB, WS_WOUT = 53 * MiB;
constexpr size_t WS_MEMN = 55 * MiB, WS_KVM = 59 * MiB, WS_COS = 63 * MiB, WS_SIN = 64 * MiB;
constexpr size_t WS_LORA = 65 * MiB;
constexpr size_t LORA_A = 65536, LORA_G = 131072;
constexpr size_t WS_XN = 66 * MiB;
constexpr size_t RO_REC = 0, RO_G = 96 * MiB, RO_VS = 112 * MiB, RO_BONUS = 128 * MiB;
constexpr int PSTR = 3600;
constexpr size_t WS_X = 130 * MiB;
constexpr size_t WS_R = 322 * MiB;
constexpr size_t WS_Y = 462 * MiB;
constexpr size_t WS_END = 510 * MiB;
constexpr size_t XO_PRW = 0, XO_QS = 56 * MiB, XO_KVS = 72 * MiB, XO_QM = 80 * MiB, XO_GT = 96 * MiB;
constexpr int CW_BAR = 4096;

constexpr int RING_OFF = 0, RING_BYTES = 131072;
constexpr int LDSCTL_OFF = RING_BYTES, MISC_OFF = LDSCTL_OFF + 320;
constexpr int LDS_BYTES = 147456;
#define GAS __attribute__((address_space(1)))
#define LAS __attribute__((address_space(3)))
typedef unsigned short bf16;
typedef unsigned v4u __attribute__((ext_vector_type(4)));
typedef float f32x4 __attribute__((ext_vector_type(4)));
typedef short bf16x8 __attribute__((ext_vector_type(8)));
typedef GAS unsigned gu32;
typedef GAS unsigned long long gu64;
#define RLX_AGENT __ATOMIC_RELAXED, __HIP_MEMORY_SCOPE_AGENT
#define LDS_WAIT() asm volatile("s_waitcnt lgkmcnt(0)" ::: "memory")
#define VM_WAIT() asm volatile("s_waitcnt vmcnt(0)" ::: "memory")
__device__ __forceinline__ unsigned long long rt() { return __builtin_amdgcn_s_memrealtime(); }
__device__ __forceinline__ unsigned f2bf(float f) { unsigned u = __builtin_bit_cast(unsigned, f); return (u + 0x7fffu + ((u >> 16) & 1u)) >> 16; }
__device__ __forceinline__ unsigned pk2(float lo, float hi) { return f2bf(lo) | (f2bf(hi) << 16); }

#define XB_TMO      128
#define XB_XCNT(j)  (256  + 64 * (j))
#define XB_XSUB(j)  (1280 + 64 * (j))
#define XB_XGEN(j)  (2304 + 64 * (j))
#define XB_TOP      3328
#define XB_TOPGEN   3392
#define XCD_BAR_WORDS 3456
#define XB_SPIN_CAP (1u << 18)

__device__ __forceinline__ unsigned xb_ld(unsigned* p)              { return __hip_atomic_load(p, __ATOMIC_RELAXED, __HIP_MEMORY_SCOPE_AGENT); }
__device__ __forceinline__ unsigned xb_add(unsigned* p, unsigned v) { return __hip_atomic_fetch_add(p, v, __ATOMIC_RELAXED, __HIP_MEMORY_SCOPE_AGENT); }
__device__ __forceinline__ unsigned xb_xcc_id() { return (unsigned)__builtin_amdgcn_s_getreg((3 << 11) | 20) & 0xFu; }
#define XB_SPIN(cond, bar) do { unsigned _sp = 0; while (cond) { __builtin_amdgcn_s_sleep(1); \
    if ((++_sp & 255u) == 0u) { if (xb_ld(&(bar)[XB_TMO])) break; if (_sp > XB_SPIN_CAP) { atomicAdd(&(bar)[XB_TMO], 1u); break; } } } } while (0)

struct XcdBarrier {
    unsigned* bar; unsigned x;
    volatile LAS unsigned* st;
};

__device__ __forceinline__ XcdBarrier xcd_barrier_post(unsigned* bar, volatile LAS unsigned* st) {
    XcdBarrier b; b.bar = bar; b.x = xb_xcc_id(); b.st = st;
    if (threadIdx.x == 0) (void)xb_add(&bar[XB_XCNT(b.x)], 1u);
    return b;
}
__device__ __forceinline__ void xcd_barrier_complete(unsigned* bar, unsigned x, unsigned& nloc, unsigned& nx) {
    const unsigned G = gridDim.x * gridDim.y * gridDim.z;
    unsigned sum, cnt, mine, sp = 0u;
    for (;;) {
        sum = 0u; cnt = 0u; mine = 0u;
#pragma unroll
        for (unsigned j = 0; j < 16; ++j) { const unsigned c = xb_ld(&bar[XB_XCNT(j)]); sum += c; cnt += (c > 0u) ? 1u : 0u; mine = (j == x) ? c : mine; }
        if (sum == G) break;
        __builtin_amdgcn_s_sleep(1);
        if ((++sp & 255u) == 0u) { if (xb_ld(&bar[XB_TMO])) break; if (sp > XB_SPIN_CAP) { atomicAdd(&bar[XB_TMO], 1u); break; } }
    }
    nloc = mine > 0u ? mine : 1u; nx = cnt > 0u ? cnt : 1u;
}

__device__ __forceinline__ void xcd_barrier(const XcdBarrier& b) {
    asm volatile("s_waitcnt vmcnt(0)" ::: "memory");
    __syncthreads();
    if (threadIdx.x == 0) {
        unsigned* bar = b.bar;
        __builtin_amdgcn_s_waitcnt(0);
        unsigned nloc = b.st[0], nx = b.st[1];
        if (nloc == 0u) { xcd_barrier_complete(bar, b.x, nloc, nx); b.st[0] = nloc; b.st[1] = nx; }
        const unsigned old = xb_add(&bar[XB_XSUB(b.x)], 1u);
        const unsigned gen = old / nloc;
        if (old + 1u == (gen + 1u) * nloc) {
            __builtin_amdgcn_fence(__ATOMIC_RELEASE, "agent");
            asm volatile("s_waitcnt vmcnt(0)" ::: "memory");
            const unsigned og = xb_add(&bar[XB_TOP], 1u);
            const unsigned tg = og / nx;
            if (og + 1u == (tg + 1u) * nx) xb_add(&bar[XB_TOPGEN], 1u);
            else XB_SPIN(xb_ld(&bar[XB_TOPGEN]) == tg, bar);
            __builtin_amdgcn_fence(__ATOMIC_ACQUIRE, "agent");
            xb_add(&bar[XB_XGEN(b.x)], 1u);
            asm volatile("s_waitcnt vmcnt(0)" ::: "memory");
        } else {
            XB_SPIN(xb_ld(&bar[XB_XGEN(b.x)]) == gen, bar);
            __builtin_amdgcn_fence(__ATOMIC_ACQUIRE, "agent");
            asm volatile("s_waitcnt vmcnt(0)" ::: "memory");
        }
    }
    __syncthreads();
}

struct Frame {
    LAS unsigned char* lds;
    volatile LAS unsigned* MISC;
    gu32* ctl;
    int tid, lane, wave;
    int vcu, G;
};
__device__ __forceinline__ float wave_sum(float v) {
#pragma unroll
    for (int o = 1; o < 64; o <<= 1) v += __shfl_xor(v, o);
    return v;
}
__device__ __forceinline__ float bf2f(bf16 v) { return __uint_as_float(((unsigned)v) << 16); }
__device__ __forceinline__ float sigm(float x) { return 1.0f / (1.0f + __expf(-x)); }

__device__ __forceinline__ void p0_transpose_item(const float* W, int K, int N, bf16* WT, int k0, int n0, int drow0, LAS float* scr, int lane) {
#pragma unroll 8
    for (int i = 0; i < 32; ++i) { const int kk = 2 * i + (lane >> 5); scr[kk * 33 + (lane & 31)] = W[(size_t)(k0 + kk) * N + n0 + (lane & 31)]; }
    LDS_WAIT(); asm volatile("" ::: "memory");
    const int c = lane & 7;
#pragma unroll
    for (int j = 0; j < 4; ++j) { const int n = (lane >> 3) + 8 * j; const LAS float* s = scr + (8 * c) * 33 + n;
        v4u o; o.x = pk2(s[0 * 33], s[1 * 33]); o.y = pk2(s[2 * 33], s[3 * 33]); o.z = pk2(s[4 * 33], s[5 * 33]); o.w = pk2(s[6 * 33], s[7 * 33]);
        *(GAS v4u*)(WT + (size_t)(drow0 + n) * K + k0 + 8 * c) = o; }
    LDS_WAIT(); asm volatile("" ::: "memory");
}
template <bool SWIGLU>
__device__ __forceinline__ void p0_transpose(const float* W, int K, int N, bf16* WT, LAS float* scr, int gw, int NGW, int lane) {
    const int nblk = N / 32, nitems = (K / 64) * nblk;
    for (int it = gw; it < nitems; it += NGW) {
        const int kb = it / nblk, nb = it % nblk, n0 = 32 * nb; int drow0 = n0;
        if (SWIGLU) { const int up = n0 >= DFF, j = up ? n0 - DFF : n0; drow0 = 256 * (j / 128) + 128 * up + (j % 128); }
        p0_transpose_item(W, K, N, WT, 64 * kb, n0, drow0, scr, lane);
    }
}
__device__ __forceinline__ void rms_row_to_bf16(const float* xrow, const float* g, bf16* orow, int lane) {
    const GAS f32x4* xr = (const GAS f32x4*)xrow + lane; const GAS f32x4* gr = (const GAS f32x4*)g + lane;
    f32x4 v[4]; float s = 0.f;
#pragma unroll
    for (int j = 0; j < 4; ++j) { v[j] = xr[64 * j]; s += (v[j].x * v[j].x + v[j].y * v[j].y) + (v[j].z * v[j].z + v[j].w * v[j].w); }
    const float r = 1.0f / sqrtf(wave_sum(s) * (1.f / D) + 1e-6f);
    GAS unsigned long long* o8 = (GAS unsigned long long*)orow + lane;
#pragma unroll
    for (int j = 0; j < 4; ++j) { const f32x4 gg = gr[64 * j]; o8[64 * j] = (unsigned long long)pk2(v[j].x * r * gg.x, v[j].y * r * gg.y) | ((unsigned long long)pk2(v[j].z * r * gg.z, v[j].w * r * gg.w) << 32); }
}
__device__ __forceinline__ void norm_res_row(const float* Frow, const float* base, float alpha, const float* g1, float* hout, const float* g2, bf16* xn, int lane) {
    const GAS f32x4* fr = (const GAS f32x4*)Frow + lane; const GAS f32x4* br = (const GAS f32x4*)base + lane; const GAS f32x4* g1r = (const GAS f32x4*)g1 + lane;
    f32x4 v[4], b[4]; float s = 0.f;
#pragma unroll
    for (int j = 0; j < 4; ++j) { v[j] = fr[64 * j]; b[j] = br[64 * j]; s += (v[j].x * v[j].x + v[j].y * v[j].y) + (v[j].z * v[j].z + v[j].w * v[j].w); }
    const float r = alpha / sqrtf(wave_sum(s) * (1.f / D) + 1e-6f); float s2 = 0.f;
#pragma unroll
    for (int j = 0; j < 4; ++j) { const f32x4 gg = g1r[64 * j]; v[j] = b[j] + v[j] * r * gg; s2 += (v[j].x * v[j].x + v[j].y * v[j].y) + (v[j].z * v[j].z + v[j].w * v[j].w); }
    GAS f32x4* ho = (GAS f32x4*)hout + lane;
#pragma unroll
    for (int j = 0; j < 4; ++j) ho[64 * j] = v[j];
    if (xn) {
        const float r2 = 1.0f / sqrtf(wave_sum(s2) * (1.f / D) + 1e-6f); const GAS f32x4* g2r = (const GAS f32x4*)g2 + lane;
        GAS unsigned long long* o8 = (GAS unsigned long long*)xn + lane;
#pragma unroll
        for (int j = 0; j < 4; ++j) { const f32x4 gg = g2r[64 * j]; o8[64 * j] = (unsigned long long)pk2(v[j].x * r2 * gg.x, v[j].y * r2 * gg.y) | ((unsigned long long)pk2(v[j].z * r2 * gg.z, v[j].w * r2 * gg.w) << 32); }
    }
}

struct MixIn {
    const bf16 *Prw, *Qs, *KVs, *Qm, *KVm; const float *cosT, *sinT;
    const float *mu, *w0, *w_up, *a0, *a_up, *g_up, *k_k, *k_a, *r_k, *gn_g, *gn_b, *sinks;
    bf16 *Ya, *Yb, *Yc; int half;
};
__device__ __forceinline__ float rl(float v, int k) { return __uint_as_float((unsigned)__builtin_amdgcn_readlane((int)__float_as_uint(v), k)); }
__device__ __forceinline__ void rwkv_naive_wave(const MixIn& X, int bh, int lane) {
    const int bl = bh >> 3, h = bh & 7, hj = h * 64 + lane;
    const float mu_r = X.mu[hj], mu_k = X.mu[512 + hj], mu_v = X.mu[1024 + hj], mu_w = X.mu[1536 + lane], mu_a = X.mu[1600 + lane], mu_g0 = X.mu[1664 + lane], mu_g1 = X.mu[1728 + lane];
    const float w0 = X.w0[hj], a0 = X.a0[hj], k_k = X.k_k[hj], k_a = X.k_a[hj], r_k = X.r_k[hj], gn_g = X.gn_g[hj], gn_b = X.gn_b[hj];
    float pr = 0.f, pk = 0.f, pv = 0.f, pw = 0.f, pa = 0.f, pg0 = 0.f, pg1 = 0.f;
    float S[64];
#pragma unroll
    for (int k = 0; k < 64; ++k) S[k] = 0.f;
    for (int t = 0; t < SEQ; ++t) {
        const size_t row = (size_t)bl * SEQ + t; const bf16* P = X.Prw + row * 1792;
        const float cr = bf2f(P[hj]), ck = bf2f(P[512 + hj]), cv = bf2f(P[1024 + hj]), cw = bf2f(P[1536 + lane]), ca = bf2f(P[1600 + lane]), cg0 = bf2f(P[1664 + lane]), cg1 = bf2f(P[1728 + lane]);
        const float xr = cr + (pr - cr) * mu_r, xk = ck + (pk - ck) * mu_k, xv = cv + (pv - cv) * mu_v, xw = cw + (pw - cw) * mu_w, xa = ca + (pa - ca) * mu_a, xg0 = cg0 + (pg0 - cg0) * mu_g0, xg1 = cg1 + (pg1 - cg1) * mu_g1;
        pr = cr; pk = ck; pv = cv; pw = cw; pa = ca; pg0 = cg0; pg1 = cg1;
        const float tw = tanhf(xw), s0 = sigm(xg0), s1 = sigm(xg1);
        float lw = w0, la = a0, lg = 0.f;
        for (int i = 0; i < 64; ++i) {
            lw += __shfl(tw, i) * X.w_up[i * 512 + hj];
            la += __shfl(xa, i) * X.a_up[i * 512 + hj];
            lg += __shfl(s0, i) * X.g_up[i * 512 + hj] + __shfl(s1, i) * X.g_up[(64 + i) * 512 + hj];
        }
        const float decay = __expf(-0.6065306597126334f * sigm(lw));
        const float asig = sigm(la);
        const float kkj = xk * k_k; const float nrm = sqrtf(wave_sum(kkj * kkj)); const float kk = kkj / fmaxf(nrm, 1e-12f);
        const float kt = xk * (1.0f + (asig - 1.0f) * k_a);
        const float av = -kk, bv = kk * asig;
        const float bonus = wave_sum(xr * kt * r_k);
        float sa = 0.f;
#pragma unroll
        for (int k = 0; k < 64; ++k) sa += S[k] * rl(av, k);
        float y = 0.f;
#pragma unroll
        for (int k = 0; k < 64; ++k) { S[k] = S[k] * rl(decay, k) + sa * rl(bv, k) + xv * rl(kt, k); y += S[k] * rl(xr, k); }
        const float mean = wave_sum(y) * (1.f / 64.f); const float d = y - mean; const float var = wave_sum(d * d) * (1.f / 64.f);
        float yn = d * (1.0f / sqrtf(var + 64e-5f)) * gn_g + gn_b;
        yn += bonus * xv;
        X.Ya[row * 512 + hj] = (bf16)f2bf(yn * lg);
    }
}
__device__ __forceinline__ void swa_naive_item(const MixIn& X, int m, int hq, int lane) {
    const int t = m & (SEQ - 1), hkv = hq >> 2; const size_t grow = (size_t)X.half * MH + m;
    float q = bf2f(X.Qs[(size_t)m * 512 + hq * 64 + lane]);
    { const float partner = __shfl(q, lane < 8 ? lane + 8 : (lane < 16 ? lane - 8 : lane)); const float c = X.cosT[grow * 8 + (lane & 7)], s = X.sinT[grow * 8 + (lane & 7)];
      if (lane < 8) q = q * c - partner * s; else if (lane < 16) q = q * c + partner * s; }
    q *= 0.125f;
    float mx = X.sinks[hq], l = 1.0f, o = 0.f;
    const int j0 = t >= 127 ? t - 127 : 0;
    for (int j = j0; j <= t; ++j) {
        const size_t kr = (size_t)(m - t + j), gk = grow - t + j;
        float kx = bf2f(X.KVs[kr * 256 + hkv * 64 + lane]); const float vx = bf2f(X.KVs[kr * 256 + 128 + hkv * 64 + lane]);
        { const float partner = __shfl(kx, lane < 8 ? lane + 8 : (lane < 16 ? lane - 8 : lane)); const float c = X.cosT[gk * 8 + (lane & 7)], s = X.sinT[gk * 8 + (lane & 7)];
          if (lane < 8) kx = kx * c - partner * s; else if (lane < 16) kx = kx * c + partner * s; }
        const float sc = wave_sum(q * kx);
        const float mn = fmaxf(mx, sc), f = __expf(mx - mn), p = __expf(sc - mn);
        l = l * f + p; o = o * f + p * vx; mx = mn;
    }
    X.Yb[(size_t)m * 512 + hq * 64 + lane] = (bf16)f2bf(o / l);
}
__device__ __forceinline__ void mem_naive_item(const MixIn& X, int m, int h, int lane) {
    const int bg = X.half * (BATCH / 2) + (m >> 12);
    const float sc0 = 0.08838834764831845f;
    const float q0 = bf2f(X.Qm[(size_t)m * 512 + h * 128 + lane]) * sc0, q1 = bf2f(X.Qm[(size_t)m * 512 + h * 128 + 64 + lane]) * sc0;
    float mx = -1e30f, l = 0.f, o0 = 0.f, o1 = 0.f;
    for (int j = 0; j < MEML; ++j) {
        const bf16* kv = X.KVm + (size_t)(bg * MEML + j) * 1024;
        const float sc = wave_sum(q0 * bf2f(kv[h * 128 + lane]) + q1 * bf2f(kv[h * 128 + 64 + lane]));
        const float mn = fmaxf(mx, sc), f = __expf(mx - mn), p = __expf(sc - mn);
        l = l * f + p; o0 = o0 * f + p * bf2f(kv[512 + h * 128 + lane]); o1 = o1 * f + p * bf2f(kv[512 + h * 128 + 64 + lane]); mx = mn;
    }
    X.Yc[(size_t)m * 512 + h * 128 + lane] = (bf16)f2bf(o0 / l); X.Yc[(size_t)m * 512 + h * 128 + 64 + lane] = (bf16)f2bf(o1 / l);
}


struct PrepIn {
    const bf16* Prw; const float *mu, *w0, *a0, *k_k, *k_a, *r_k; const bf16 *w_upT, *a_upT, *g_upT;
    unsigned* REC; bf16 *G, *VS; float* BONUS;
};
typedef float f32x4_t __attribute__((ext_vector_type(4)));
__device__ __forceinline__ void prep_ld8(const LAS unsigned char* lds, int i, int col0, const float* mu, float (&xs)[8]) {
    const v4u c = *(const LAS v4u*)(lds + (i + 1) * PSTR + col0 * 2), p = *(const LAS v4u*)(lds + i * PSTR + col0 * 2);
    const f32x4_t m0 = *(const GAS f32x4_t*)(mu + col0), m1 = *(const GAS f32x4_t*)(mu + col0 + 4);
#pragma unroll
    for (int j = 0; j < 4; ++j) { const float cl = __uint_as_float(c[j] << 16), ch = __uint_as_float(c[j] & 0xffff0000u), pl = __uint_as_float(p[j] << 16), ph = __uint_as_float(p[j] & 0xffff0000u);
        const float ml = (j < 2 ? m0 : m1)[(2 * j) & 3], mh = (j < 2 ? m0 : m1)[(2 * j + 1) & 3];
        xs[2 * j] = cl + (pl - cl) * ml; xs[2 * j + 1] = ch + (ph - ch) * mh; }
}
__device__ __forceinline__ bf16x8 pack8(const float (&x)[8]) { v4u w; w.x = pk2(x[0], x[1]); w.y = pk2(x[2], x[3]); w.z = pk2(x[4], x[5]); w.w = pk2(x[6], x[7]); return __builtin_bit_cast(bf16x8, w); }
__device__ __forceinline__ void rwkv_prep_phase(Frame& F, const PrepIn& X) {
    const LAS unsigned char* L = F.lds + RING_OFF; const int lane = F.lane, n = lane & 15, q = lane >> 4, h = F.wave;
    for (int item = F.vcu; item < MH / 16; item += F.G) {
        const int r0 = item * 16;
        __syncthreads();
        for (int c = F.tid; c < 17 * 224; c += NWAVES * 64) { const int rr = c / 224, ch = c % 224; v4u val = (v4u){0u, 0u, 0u, 0u};
            if (!(rr == 0 && (r0 & (SEQ - 1)) == 0)) val = *(const GAS v4u*)(X.Prw + (size_t)(r0 - 1 + rr) * 1792 + ch * 8);
            *(LAS v4u*)(F.lds + RING_OFF + rr * PSTR + ch * 16) = val; }
        __syncthreads();
        bf16x8 Aw[2], Aa[2], Ag[4]; float xs[8];
#pragma unroll
        for (int ks = 0; ks < 2; ++ks) {
            prep_ld8(L, n, 1536 + 32 * ks + 8 * q, X.mu, xs);
#pragma unroll
            for (int j = 0; j < 8; ++j) xs[j] = tanhf(xs[j]);
            Aw[ks] = pack8(xs);
            prep_ld8(L, n, 1600 + 32 * ks + 8 * q, X.mu, xs); Aa[ks] = pack8(xs); }
#pragma unroll
        for (int ks = 0; ks < 4; ++ks) { prep_ld8(L, n, 1664 + 32 * ks + 8 * q, X.mu, xs);
#pragma unroll
            for (int j = 0; j < 8; ++j) xs[j] = sigm(xs[j]);
            Ag[ks] = pack8(xs); }
        f32x4_t cw[4], ca[4], cg[4];
#pragma unroll
        for (int nt = 0; nt < 4; ++nt) { cw[nt] = (f32x4_t){0.f, 0.f, 0.f, 0.f}; ca[nt] = cw[nt]; cg[nt] = cw[nt]; const int col = h * 64 + 16 * nt + n;
#pragma unroll
            for (int ks = 0; ks < 2; ++ks) { const bf16x8 bw = *(const GAS bf16x8*)(X.w_upT + (size_t)col * 64 + 32 * ks + 8 * q), ba = *(const GAS bf16x8*)(X.a_upT + (size_t)col * 64 + 32 * ks + 8 * q);
                cw[nt] = __builtin_amdgcn_mfma_f32_16x16x32_bf16(Aw[ks], bw, cw[nt], 0, 0, 0); ca[nt] = __builtin_amdgcn_mfma_f32_16x16x32_bf16(Aa[ks], ba, ca[nt], 0, 0, 0); }
#pragma unroll
            for (int ks = 0; ks < 4; ++ks) { const bf16x8 bg = *(const GAS bf16x8*)(X.g_upT + (size_t)col * 128 + 32 * ks + 8 * q);
                cg[nt] = __builtin_amdgcn_mfma_f32_16x16x32_bf16(Ag[ks], bg, cg[nt], 0, 0, 0); } }
        float kkv[4][4], ktv[4][4], rsv[4][4], asg[4][4], n2[4], bon[4];
#pragma unroll
        for (int reg = 0; reg < 4; ++reg) { n2[reg] = 0.f; bon[reg] = 0.f; }
#pragma unroll
        for (int nt = 0; nt < 4; ++nt) { const int col = h * 64 + 16 * nt + n;
            const float mu_r = X.mu[col], mu_k = X.mu[512 + col], mu_v = X.mu[1024 + col], w0 = X.w0[col], a0 = X.a0[col], k_k = X.k_k[col], k_a = X.k_a[col], r_k = X.r_k[col];
#pragma unroll
            for (int reg = 0; reg < 4; ++reg) { const int i = 4 * q + reg; const size_t row = (size_t)(r0 + i);
                const LAS bf16* cur = (const LAS bf16*)(L + (i + 1) * PSTR); const LAS bf16* prv = (const LAS bf16*)(L + i * PSTR);
                const float cr = bf2f(cur[col]), ck = bf2f(cur[512 + col]), cv = bf2f(cur[1024 + col]), pr = bf2f(prv[col]), pk = bf2f(prv[512 + col]), pv = bf2f(prv[1024 + col]);
                const float xr = cr + (pr - cr) * mu_r, xk = ck + (pk - ck) * mu_k, xv = cv + (pv - cv) * mu_v;
                const float decay = __expf(-0.6065306597126334f * sigm(w0 + cw[nt][reg])), asig = sigm(a0 + ca[nt][reg]);
                const float kkj = xk * k_k, kt = xk * (1.0f + (asig - 1.0f) * k_a);
                kkv[nt][reg] = kkj; ktv[nt][reg] = kt; rsv[nt][reg] = xr; asg[nt][reg] = asig; n2[reg] += kkj * kkj; bon[reg] += xr * kt * r_k;
                X.REC[(row * 8 + h) * 192 + 32 + 20 * ((16 * nt + n) >> 3) + ((16 * nt + n) & 7)] = __float_as_uint(decay);
                X.G[row * 512 + col] = (bf16)f2bf(cg[nt][reg]); X.VS[row * 512 + col] = (bf16)f2bf(xv); } }
#pragma unroll
        for (int reg = 0; reg < 4; ++reg) {
#pragma unroll
            for (int o = 1; o < 16; o <<= 1) { n2[reg] += __shfl_xor(n2[reg], o); bon[reg] += __shfl_xor(bon[reg], o); }
            const float inv = 1.0f / fmaxf(sqrtf(n2[reg]), 1e-12f); const size_t row = (size_t)(r0 + 4 * q + reg);
            if (n == 0) X.BONUS[row * 8 + h] = bon[reg];
            bf16* rec16 = (bf16*)(X.REC + (row * 8 + h) * 192);
#pragma unroll
            for (int nt = 0; nt < 4; ++nt) { const float kk = kkv[nt][reg] * inv; const int e = 16 * nt + n;
                const int gb = 2 * (32 + 20 * (e >> 3)) + (e & 7);
                rec16[e] = (bf16)f2bf(-kk); rec16[gb + 16] = (bf16)f2bf(kk * asg[nt][reg]); rec16[gb + 24] = (bf16)f2bf(ktv[nt][reg]); rec16[gb + 32] = (bf16)f2bf(rsv[nt][reg]); } }
    }
    __syncthreads();
}
typedef unsigned u32x16 __attribute__((ext_vector_type(16)));
struct ChunkIn { const unsigned* REC; const bf16* VS; bf16 *YL, *QT, *SL, *PC; };
__device__ __forceinline__ float bflo(unsigned d) { return __uint_as_float(d << 16); }
__device__ __forceinline__ float bfhi(unsigned d) { return __uint_as_float(d & 0xffff0000u); }
#define SLD16(dst, ptr, off) asm volatile("s_load_dwordx16 %0, %1, %2 glc" : "=s"(dst) : "s"(ptr), "i"(off))
#define SLD4(dst, ptr, off)  asm volatile("s_load_dwordx4 %0, %1, %2 glc" : "=s"(dst) : "s"(ptr), "i"(off))
__device__ __forceinline__ void fmac_s(float& acc, float sc, float x) { asm("v_fmac_f32_e32 %0, %1, %2" : "+v"(acc) : "s"(sc), "v"(x)); }
__device__ __forceinline__ float mul_s(float sc, float x) { float r; asm("v_mul_f32_e32 %0, %1, %2" : "=v"(r) : "s"(sc), "v"(x)); return r; }
__device__ __forceinline__ void fma_s(float& st, float sc, float u) { asm("v_fma_f32 %0, %0, %1, %2" : "+v"(st) : "s"(sc), "v"(u)); }
__device__ __forceinline__ void rwkv_chunk_phase(Frame& F, const ChunkIn& X) {
    const int lane = F.lane, NGW = F.G * NWAVES;
    for (int task = F.vcu * NWAVES + F.wave; task < (MH / SEQ) * 8 * 64; task += NGW) {
        const int bh = task >> 6, c = task & 63, bl = bh >> 3, h = bh & 7, hj = h * 64 + lane;
        const size_t row0 = (size_t)bl * SEQ + (size_t)c * 64;
        const unsigned* rc = X.REC + (row0 * 8 + h) * 192;
        { unsigned lo = __builtin_amdgcn_readfirstlane((unsigned)(size_t)rc), hi = __builtin_amdgcn_readfirstlane((unsigned)((size_t)rc >> 32)); rc = (const unsigned*)(((size_t)hi << 32) | lo); }
        float S[64], T[64];
#pragma unroll
        for (int k = 0; k < 64; ++k) { S[k] = 0.f; T[k] = (k == lane) ? 1.f : 0.f; }
        float vnext = bf2f(X.VS[row0 * 512 + hj]);
        u32x16 A0, A1, Gc; v4u Rc;
        SLD16(A0, rc, 0); SLD16(A1, rc, 64); SLD16(Gc, rc, 128); SLD4(Rc, rc, 192);
        for (int t = 0; t < 64; ++t) {
            const size_t row = row0 + t; float xv = vnext;
            if (t < 63) vnext = bf2f(X.VS[(row + 1) * 512 + hj]);
            asm volatile("s_waitcnt lgkmcnt(0)" : "+s"(A0), "+s"(A1), "+s"(Gc), "+s"(Rc));
            float sa0 = 0.f, sa1 = 0.f, ta0 = 0.f, ta1 = 0.f;
#pragma unroll
            for (int i = 0; i < 16; ++i) { const float al = bflo(A0[i]), ah = bfhi(A0[i]);
                fmac_s(sa0, al, S[2 * i]); fmac_s(ta0, al, T[2 * i]); fmac_s(sa1, ah, S[2 * i + 1]); fmac_s(ta1, ah, T[2 * i + 1]); }
#pragma unroll
            for (int i = 0; i < 16; ++i) { const float al = bflo(A1[i]), ah = bfhi(A1[i]);
                fmac_s(sa0, al, S[32 + 2 * i]); fmac_s(ta0, al, T[32 + 2 * i]); fmac_s(sa1, ah, S[33 + 2 * i]); fmac_s(ta1, ah, T[33 + 2 * i]); }
            const float sa = sa0 + sa1; float ta = ta0 + ta1;
            float y0 = 0.f, y1 = 0.f, q0 = 0.f, q1 = 0.f;
            const unsigned* rn = rc + 8 * 192;
#pragma unroll
            for (int g = 0; g < 8; ++g) {
                const u32x16 Gg = Gc; const v4u Rg = Rc;
                if (g < 7) asm volatile("s_load_dwordx16 %0, %4, %5 glc\n\ts_load_dwordx4 %1, %4, %6 glc" : "=&s"(Gc), "=&s"(Rc), "+v"(xv), "+v"(ta) : "s"(rc), "i"(128 + 80 * (g + 1)), "i"(192 + 80 * (g + 1)));
                else asm volatile("s_load_dwordx16 %0, %6, 0 glc\n\ts_load_dwordx16 %1, %6, 64 glc\n\ts_load_dwordx16 %2, %6, 128 glc\n\ts_load_dwordx4 %3, %6, 192 glc" : "=&s"(A0), "=&s"(A1), "=&s"(Gc), "=&s"(Rc), "+v"(xv), "+v"(ta) : "s"(rn));
#pragma unroll
                for (int i = 0; i < 4; ++i) { const int k = 8 * g + 2 * i;
                    const float w0 = __uint_as_float(Gg[2 * i]), w1 = __uint_as_float(Gg[2 * i + 1]), b0 = bflo(Gg[8 + i]), b1 = bfhi(Gg[8 + i]), k0 = bflo(Gg[12 + i]), k1 = bfhi(Gg[12 + i]), r0 = bflo(Rg[i]), r1 = bfhi(Rg[i]);
                    float u0 = mul_s(k0, xv); fmac_s(u0, b0, sa); fma_s(S[k], w0, u0); fmac_s(y0, r0, S[k]);
                    float u1 = mul_s(k1, xv); fmac_s(u1, b1, sa); fma_s(S[k + 1], w1, u1); fmac_s(y1, r1, S[k + 1]);
                    float z0 = mul_s(b0, ta); fma_s(T[k], w0, z0); fmac_s(q0, r0, T[k]);
                    float z1 = mul_s(b1, ta); fma_s(T[k + 1], w1, z1); fmac_s(q1, r1, T[k + 1]); }
                if (g < 7) asm volatile("s_waitcnt lgkmcnt(0)" : "+s"(Gc), "+s"(Rc), "+v"(y0), "+v"(y1), "+v"(q0), "+v"(q1));
            }
            X.YL[row * 512 + hj] = (bf16)f2bf(y0 + y1); X.QT[row * 512 + hj] = (bf16)f2bf(q0 + q1);
            rc = rn;
        }
        asm volatile("s_waitcnt lgkmcnt(0)" : "+s"(A0), "+s"(A1), "+s"(Gc), "+s"(Rc));
        v4u* sl = (v4u*)(X.SL + ((size_t)task * 64 + lane) * 64); v4u* pc = (v4u*)(X.PC + ((size_t)task * 64 + lane) * 64);
#pragma unroll
        for (int i = 0; i < 8; ++i) { v4u a, b;
            a.x = pk2(S[8 * i], S[8 * i + 1]); a.y = pk2(S[8 * i + 2], S[8 * i + 3]); a.z = pk2(S[8 * i + 4], S[8 * i + 5]); a.w = pk2(S[8 * i + 6], S[8 * i + 7]);
            b.x = pk2(T[8 * i], T[8 * i + 1]); b.y = pk2(T[8 * i + 2], T[8 * i + 3]); b.z = pk2(T[8 * i + 4], T[8 * i + 5]); b.w = pk2(T[8 * i + 6], T[8 * i + 7]);
            sl[i] = a; pc[i] = b; }
    }
}
struct CrossIn { const bf16 *SL, *PC; bf16* S0; };
__device__ __forceinline__ void rwkv_cross_phase(Frame& F, const CrossIn& X) {
    const int lane = F.lane, NGW = F.G * NWAVES;
    for (int task = F.vcu * NWAVES + F.wave; task < (MH / SEQ) * 8 * 64; task += NGW) {
        const int bh = task >> 6, v = task & 63;
        float s = 0.f;
        X.S0[(((size_t)bh * 64) * 64 + v) * 64 + lane] = (bf16)0;
        for (int c = 0; c < 63; ++c) {
            const bf16* P = X.PC + ((size_t)(bh * 64 + c) * 64) * 64 + lane;
            float acc0 = bf2f(X.SL[(((size_t)(bh * 64 + c)) * 64 + v) * 64 + lane]), acc1 = 0.f;
#pragma unroll
            for (int j = 0; j < 64; j += 2) { acc0 += rl(s, j) * bf2f(P[j * 64]); acc1 += rl(s, j + 1) * bf2f(P[(j + 1) * 64]); }
            s = acc0 + acc1;
            X.S0[(((size_t)(bh * 64 + c + 1)) * 64 + v) * 64 + lane] = (bf16)f2bf(s);
        }
    }
}
struct FinIn { const bf16 *YL, *QT, *S0, *G, *VS; const float *BONUS, *gn_g, *gn_b; bf16* Ya; };
__device__ __forceinline__ void rwkv_final_phase(Frame& F, const FinIn& X) {
    const int lane = F.lane, n = lane & 15, q = lane >> 4, NGW = F.G * NWAVES;
    for (int task = F.vcu * NWAVES + F.wave; task < (MH / SEQ) * 8 * 64; task += NGW) {
        const int bh = task >> 6, c = task & 63, bl = bh >> 3, h = bh & 7;
        const size_t row0 = (size_t)bl * SEQ + (size_t)c * 64;
        f32x4_t acc[4][4];
#pragma unroll
        for (int mt = 0; mt < 4; ++mt)
#pragma unroll
            for (int nt = 0; nt < 4; ++nt) acc[mt][nt] = (f32x4_t){0.f, 0.f, 0.f, 0.f};
        if (c > 0) {
#pragma unroll
            for (int ks = 0; ks < 2; ++ks) { bf16x8 a[4], b[4];
#pragma unroll
                for (int mt = 0; mt < 4; ++mt) a[mt] = *(const GAS bf16x8*)(X.QT + (row0 + 16 * mt + n) * 512 + h * 64 + 32 * ks + 8 * q);
#pragma unroll
                for (int nt = 0; nt < 4; ++nt) b[nt] = *(const GAS bf16x8*)(X.S0 + ((size_t)task * 64 + 16 * nt + n) * 64 + 32 * ks + 8 * q);
#pragma unroll
                for (int mt = 0; mt < 4; ++mt)
#pragma unroll
                    for (int nt = 0; nt < 4; ++nt) acc[mt][nt] = __builtin_amdgcn_mfma_f32_16x16x32_bf16(a[mt], b[nt], acc[mt][nt], 0, 0, 0); } }
        float gg[4], gb[4];
#pragma unroll
        for (int nt = 0; nt < 4; ++nt) { gg[nt] = X.gn_g[h * 64 + 16 * nt + n]; gb[nt] = X.gn_b[h * 64 + 16 * nt + n]; }
#pragma unroll
        for (int mt = 0; mt < 4; ++mt)
#pragma unroll
            for (int reg = 0; reg < 4; ++reg) { const size_t row = row0 + 16 * mt + 4 * q + reg; float y[4], sum = 0.f;
#pragma unroll
                for (int nt = 0; nt < 4; ++nt) { y[nt] = acc[mt][nt][reg] + bf2f(X.YL[row * 512 + h * 64 + 16 * nt + n]); sum += y[nt]; }
#pragma unroll
                for (int o = 1; o < 16; o <<= 1) sum += __shfl_xor(sum, o);
                const float mean = sum * (1.f / 64.f); float var = 0.f;
#pragma unroll
                for (int nt = 0; nt < 4; ++nt) { y[nt] -= mean; var += y[nt] * y[nt]; }
#pragma unroll
                for (int o = 1; o < 16; o <<= 1) var += __shfl_xor(var, o);
                const float rstd = 1.0f / sqrtf(var * (1.f / 64.f) + 64e-5f), bonus = X.BONUS[row * 8 + h];
#pragma unroll
                for (int nt = 0; nt < 4; ++nt) { const size_t e = row * 512 + h * 64 + 16 * nt + n;
                    const float yn = y[nt] * rstd * gg[nt] + gb[nt] + bonus * bf2f(X.VS[e]);
                    X.Ya[e] = (bf16)f2bf(yn * bf2f(X.G[e])); } }
    }
}

struct Args { const void* in[31]; float* out; unsigned char* ws; int ph_lo, ph_hi; };
constexpr int NSUB = 8, PH_MIX0 = 4, PH_FFN2 = PH_MIX0 + 2 * NSUB, NPH = PH_FFN2 + 3;
typedef __attribute__((address_space(4))) const unsigned char* kptr_t;
struct KA { kptr_t p;
    __device__ __forceinline__ const void* operator[](int i) const { return *(const void* const __attribute__((address_space(4)))*)(p + 8 * i); } };
struct ArgsView { KA in; float* out; unsigned char* ws; };
__device__ __forceinline__ ArgsView args_view() {
    kptr_t p = (kptr_t)__builtin_amdgcn_kernarg_segment_ptr(); asm volatile("" : "+s"(p));
    ArgsView a; a.in.p = p; a.out = (float*)a.in[31]; a.ws = (unsigned char*)a.in[32]; return a; }
extern __shared__ __attribute__((aligned(16))) unsigned char lds_dyn[];
__device__ __forceinline__ void frame_fill(Frame& F, const ArgsView& args) {
    F.lds = (LAS unsigned char*)lds_dyn;
    F.MISC = (volatile LAS unsigned*)(F.lds + MISC_OFF);
    { int t_ = threadIdx.x; asm volatile("" : "+v"(t_)); F.tid = t_; } F.lane = F.tid & 63; F.wave = __builtin_amdgcn_readfirstlane(F.tid >> 6);
    F.G = gridDim.x; { int bx = blockIdx.x; asm volatile("" : "+s"(bx)); F.vcu = (F.G % 8 == 0) ? (bx % 8) * (F.G / 8) + bx / 8 : bx; }
    F.ctl = (gu32*)(args.ws + WS_CTL);
}
__device__ __forceinline__ XcdBarrier bar_view() {
    const ArgsView args = args_view();
    XcdBarrier b; b.bar = (unsigned*)((gu32*)(args.ws + WS_CTL) + CW_BAR); b.x = xb_xcc_id(); b.st = (volatile LAS unsigned*)((LAS unsigned char*)lds_dyn + MISC_OFF) + 8; return b;
}
template <int PH>
__device__ __forceinline__ void run_phase() {
    const ArgsView args = args_view();
    Frame F; frame_fill(F, args);
    unsigned char* ws = args.ws;
    float* out = args.out;
    bf16* XN = (bf16*)(ws + WS_XN); bf16* HB = (bf16*)(ws + WS_X); float* FB = (float*)(ws + WS_R);
    bf16* PRW = (bf16*)(ws + WS_X + XO_PRW); bf16* QS = (bf16*)(ws + WS_X + XO_QS); bf16* KVS = (bf16*)(ws + WS_X + XO_KVS); bf16* QM = (bf16*)(ws + WS_X + XO_QM); bf16* GT = (bf16*)(ws + WS_X + XO_GT);
    bf16* MERGED = (bf16*)(ws + WS_R); float* FH = (float*)(ws + WS_R + 32 * MiB);
    bf16* YA = (bf16*)(ws + WS_Y); bf16* YB = QS; bf16* YC = QM;
    bf16* SLB = (bf16*)(ws + WS_Y + 16 * MiB); bf16* PCB = (bf16*)(ws + WS_Y + 32 * MiB);
    bf16* YLB = (bf16*)(ws + WS_X + XO_PRW); bf16* QTB = (bf16*)(ws + WS_X + XO_PRW + 16 * MiB); bf16* S0B = (bf16*)(ws + WS_X + XO_PRW + 32 * MiB);
    bf16* WBR = (bf16*)(ws + WS_WBR); bf16* KVM = (bf16*)(ws + WS_KVM);
    const int gw = F.vcu * NWAVES + F.wave, NGW = F.G * NWAVES;
    if constexpr (PH == 0) {
        const float* x = (const float*)args.in[0]; const float* mem = (const float*)args.in[1]; const int* positions = (const int*)args.in[2];
        bf16* MEMN = (bf16*)(ws + WS_MEMN); float* COS = (float*)(ws + WS_COS); float* SIN = (float*)(ws + WS_SIN);
        LAS float* scr = (LAS float*)(F.lds + RING_OFF + F.wave * 16384);
        p0_transpose<true>((const float*)args.in[4], D, 2 * DFF, (bf16*)(ws + WS_W1A), scr, gw, NGW, F.lane);
        p0_transpose<false>((const float*)args.in[5], DFF, D, (bf16*)(ws + WS_W2A), scr, gw, NGW, F.lane);
        p0_transpose<true>((const float*)args.in[28], D, 2 * DFF, (bf16*)(ws + WS_W1B), scr, gw, NGW, F.lane);
        p0_transpose<false>((const float*)args.in[29], DFF, D, (bf16*)(ws + WS_W2B), scr, gw, NGW, F.lane);
        p0_transpose<false>((const float*)args.in[8], D, INCOLS, (bf16*)(ws + WS_WIN), scr, gw, NGW, F.lane);
        p0_transpose<false>((const float*)args.in[23], D, D, (bf16*)(ws + WS_WKV), scr, gw, NGW, F.lane);
        for (int br = 0; br < 3; ++br) p0_transpose<false>((const float*)args.in[24] + (size_t)br * 512 * D, 512, D, WBR + (size_t)br * D * 512, scr, gw, NGW, F.lane);
        p0_transpose<false>((const float*)args.in[25], D, D, (bf16*)(ws + WS_WOUT), scr, gw, NGW, F.lane);
        for (int m = gw; m < MTOK; m += NGW) rms_row_to_bf16(x + (size_t)m * D, (const float*)args.in[3], XN + (size_t)m * D, F.lane);
        for (int m = gw; m < MEMROWS; m += NGW) rms_row_to_bf16(mem + (size_t)m * D, (const float*)args.in[22], MEMN + (size_t)m * D, F.lane);
        { const float* w_up = (const float*)args.in[12]; const float* a_up = (const float*)args.in[14]; const float* g_up = (const float*)args.in[15];
          bf16* LW = (bf16*)(ws + WS_LORA); bf16* LA = (bf16*)(ws + WS_LORA + LORA_A); bf16* LG = (bf16*)(ws + WS_LORA + LORA_G);
          for (int i = blockIdx.x * (NWAVES * 64) + F.tid; i < 512 * 128; i += F.G * NWAVES * 64) {
              if (i < 512 * 64) { const int nn = i >> 6, kk = i & 63; LW[i] = (bf16)f2bf(w_up[kk * 512 + nn]); LA[i] = (bf16)f2bf(a_up[kk * 512 + nn]); }
              { const int nn = i >> 7, kk = i & 127; LG[i] = (bf16)f2bf(g_up[kk * 512 + nn]); } } }
        for (int i = blockIdx.x * (NWAVES * 64) + F.tid; i < MTOK * 8; i += F.G * NWAVES * 64) {
            const int tok = i >> 3, f = i & 7; const double inv = pow(500000.0, -(double)f / 8.0); const double ang = (double)positions[tok] * inv;
            COS[i] = (float)cos(ang); SIN[i] = (float)sin(ang); }
    } else if constexpr (PH == 1 || PH == PH_FFN2) {
        pg8::Gemm g{XN, (const bf16*)(ws + (PH == 1 ? WS_W1A : WS_W1B)), MTOK, 2 * DFF, D}; pg8::StaticOrder S; S.init(MTOK, 2 * DFF, F.G, (int)blockIdx.x);
        pg8::EpiSwiglu E{HB, DFF};
        pg8::gemm_phase<pg8::EpiSwiglu, pg8::StaticOrder, PG8_ALIGN, PG8_SP2>(F.lds + RING_OFF, g, S, E);
        if constexpr (PH == 1) {
            pg8::Gemm g2{(const bf16*)(ws + WS_MEMN), (const bf16*)(ws + WS_WKV), MEMROWS, D, D}; pg8::StaticOrder S2; S2.init(MEMROWS, D, F.G, (int)blockIdx.x);
            pg8::EpiBf16Plain E2{KVM, D};
            pg8::gemm_phase<pg8::EpiBf16Plain, pg8::StaticOrder, PG8_ALIGN, PG8_SP2>(F.lds + RING_OFF, g2, S2, E2);
        }
    } else if constexpr (PH == 2 || PH == PH_FFN2 + 1) {
        pg8::Gemm g{HB, (const bf16*)(ws + (PH == 2 ? WS_W2A : WS_W2B)), MTOK, D, DFF}; pg8::StaticOrder S; S.init(MTOK, D, F.G, (int)blockIdx.x);
        pg8::EpiF32 E{FB, D};
        pg8::gemm_phase<pg8::EpiF32, pg8::StaticOrder, PG8_ALIGN, PG8_SP2>(F.lds + RING_OFF, g, S, E);
    } else if constexpr (PH == 3) {
        const float* x = (const float*)args.in[0];
        for (int m = gw; m < MTOK; m += NGW) norm_res_row(FB + (size_t)m * D, x + (size_t)m * D, 0.5f, (const float*)args.in[6], out + (size_t)m * D, (const float*)args.in[7], XN + (size_t)m * D, F.lane);
    } else if constexpr (PH == PH_FFN2 + 2) {
        for (int m = gw; m < MTOK; m += NGW) norm_res_row(FB + (size_t)m * D, out + (size_t)m * D, 0.5f, (const float*)args.in[30], out + (size_t)m * D, nullptr, nullptr, F.lane);
    } else {
        constexpr int hh = (PH - PH_MIX0) / NSUB, sub = (PH - PH_MIX0) % NSUB; constexpr size_t roff = (size_t)hh * MH;
        if constexpr (sub == 0) {
            pg8::Gemm g{XN + roff * D, (const bf16*)(ws + WS_WIN), MH, INCOLS, D}; pg8::StaticOrder S; S.init(MH, INCOLS, F.G, (int)blockIdx.x);
            pg8::EpiProj E{PRW, QS, KVS, QM, GT, (const float*)args.in[9]};
            pg8::gemm_phase<pg8::EpiProj, pg8::StaticOrder, PG8_ALIGN, PG8_SP2>(F.lds + RING_OFF, g, S, E);
        } else if constexpr (sub == 1) {
            PrepIn X; X.Prw = PRW; X.mu = (const float*)args.in[10]; X.w0 = (const float*)args.in[11]; X.a0 = (const float*)args.in[13]; X.k_k = (const float*)args.in[16]; X.k_a = (const float*)args.in[17]; X.r_k = (const float*)args.in[18];
            X.w_upT = (const bf16*)(ws + WS_LORA); X.a_upT = (const bf16*)(ws + WS_LORA + LORA_A); X.g_upT = (const bf16*)(ws + WS_LORA + LORA_G);
            X.REC = (unsigned*)(ws + WS_R + RO_REC); X.G = (bf16*)(ws + WS_R + RO_G); X.VS = (bf16*)(ws + WS_R + RO_VS); X.BONUS = (float*)(ws + WS_R + RO_BONUS);
            rwkv_prep_phase(F, X);
        } else if constexpr (sub == 2) {
            ChunkIn X; X.REC = (const unsigned*)(ws + WS_R + RO_REC); X.VS = (const bf16*)(ws + WS_R + RO_VS); X.YL = YLB; X.QT = QTB; X.SL = SLB; X.PC = PCB;
            rwkv_chunk_phase(F, X);
        } else if constexpr (sub == 3) {
            { CrossIn Z; Z.SL = SLB; Z.PC = PCB; Z.S0 = S0B; rwkv_cross_phase(F, Z); }
            MixIn X; X.Prw = PRW; X.Qs = QS; X.KVs = KVS; X.Qm = QM; X.KVm = KVM; X.cosT = (const float*)(ws + WS_COS); X.sinT = (const float*)(ws + WS_SIN);
            X.sinks = (const float*)args.in[21]; X.Ya = YA; X.Yb = YB; X.Yc = YC; X.half = hh;
            for (int it = gw; it < MH * 8; it += NGW) swa_naive_item(X, it >> 3, it & 7, F.lane);
            for (int it = gw; it < MH * 4; it += NGW) mem_naive_item(X, it >> 2, it & 3, F.lane);
        } else if constexpr (sub == 4) {
            FinIn Z; Z.YL = YLB; Z.QT = QTB; Z.S0 = S0B; Z.G = (const bf16*)(ws + WS_R + RO_G); Z.VS = (const bf16*)(ws + WS_R + RO_VS); Z.BONUS = (const float*)(ws + WS_R + RO_BONUS);
            Z.gn_g = (const float*)args.in[19]; Z.gn_b = (const float*)args.in[20]; Z.Ya = YA; rwkv_final_phase(F, Z);
        } else if constexpr (sub == 5) {
            for (int br = 0; br < 3; ++br) {
                pg8::Gemm g{br == 0 ? YA : (br == 1 ? YB : YC), WBR + (size_t)br * D * 512, MH, D, 512}; pg8::StaticOrder S; S.init(MH, D, F.G, (int)blockIdx.x);
                pg8::EpiMerge E{MERGED, GT, br * 1024, br == 0};
                pg8::gemm_phase<pg8::EpiMerge, pg8::StaticOrder, PG8_ALIGN, PG8_SP2>(F.lds + RING_OFF, g, S, E);
            }
        } else if constexpr (sub == 6) {
            pg8::Gemm g{MERGED, (const bf16*)(ws + WS_WOUT), MH, D, D}; pg8::StaticOrder S; S.init(MH, D, F.G, (int)blockIdx.x);
            pg8::EpiF32 E{FH, D};
            pg8::gemm_phase<pg8::EpiF32, pg8::StaticOrder, PG8_ALIGN, PG8_SP2>(F.lds + RING_OFF, g, S, E);
        } else {
            for (int m = gw; m < MH; m += NGW) norm_res_row(FH + (size_t)m * D, out + (roff + m) * D, 1.0f, (const float*)args.in[26], out + (roff + m) * D, (const float*)args.in[27], XN + (roff + m) * D, F.lane);
        }
    }
}
template <int PH>
__device__ __forceinline__ void run_from() {
    run_phase<PH>();
    if constexpr (PH + 1 < NPH) { xcd_barrier(bar_view()); run_from<PH + 1>(); }
}
__global__ void __launch_bounds__(NWAVES * 64, 2) fwd_all(Args args) {
    { LAS unsigned char* l = (LAS unsigned char*)lds_dyn;
      for (int u = threadIdx.x; u < (LDS_BYTES - LDSCTL_OFF) / 4; u += NWAVES * 64) ((LAS unsigned*)(l + LDSCTL_OFF))[u] = 0u;
      __syncthreads();
      const XcdBarrier b = bar_view(); (void)xcd_barrier_post(b.bar, b.st); }
    run_from<0>();
}

extern "C" void kernel_launch(void* const* d_in, const int* in_sizes, int n_in, void* d_out, int out_size, void* d_ws, size_t ws_size, hipStream_t stream) {
    static int grid = 0;
    if (grid == 0) {
        if (n_in != 31 || out_size != MTOK * D || ws_size < WS_END) { fprintf(stderr, "kernel_launch: unexpected shapes (n_in %d out %d ws %zu)\n", n_in, out_size, ws_size); grid = -1; return; }
        int dev = 0, cus = 0;
        if (hipGetDevice(&dev) != hipSuccess || hipDeviceGetAttribute(&cus, hipDeviceAttributeMultiprocessorCount, dev) != hipSuccess) { grid = -1; return; }
        if (hipFuncSetAttribute((const void*)fwd_all, hipFuncAttributeMaxDynamicSharedMemorySize, LDS_BYTES) != hipSuccess) { fprintf(stderr, "kernel_launch: hipFuncSetAttribute failed\n"); grid = -1; return; }
        (void)hipGetLastError();
        grid = cus;
    }
    if (grid < 0) return;
    (void)hipMemsetAsync((char*)d_ws + WS_CTL, 0, CTL_ZERO_BYTES, stream);
    Args a{};
    for (int i = 0; i < 31; ++i) a.in[i] = d_in[i];
    a.out = (float*)d_out; a.ws = (unsigned char*)d_ws; a.ph_lo = 0; a.ph_hi = NPH;
    hipLaunchKernelGGL(fwd_all, dim3(grid), dim3(NWAVES * 64), LDS_BYTES, stream, a);
}
```

```cpp
#include <hip/hip_runtime.h>
#include <cstdio>
#include <cstdint>
#include <cmath>
namespace pg8 {
#define PG8_LAS __attribute__((address_space(3)))
typedef unsigned short bf16_t;
typedef short bf16x8 __attribute__((ext_vector_type(8)));
typedef float f32x4 __attribute__((ext_vector_type(4)));
typedef unsigned u32x4 __attribute__((ext_vector_type(4)));
constexpr int BM = 256, BK = 64, HALF = 128, HTB = HALF * BK * 2  , STAGE_BYTES = 8 * HTB, NXCD = 8, WGM = 8;

__host__ __device__ __forceinline__ int lds_byte(int r, int c) { const int st = (r >> 4) * 2 + (c >> 5), rr = r & 15, cc = c & 31, ob = rr * 64 + cc * 2; return st * 1024 + (ob ^ (((ob >> 9) & 1) << 5)); }
__host__ __device__ __forceinline__ void stage_rc(int b, int& R, int& C) { const int st = b / 1024, sb = b % 1024, swz = sb ^ (((sb >> 9) & 1) << 5); R = (st >> 1) * 16 + swz / 64; C = (st & 1) * 32 + (swz % 64) / 2; }
__host__ __device__ __forceinline__ int perm32(int rho) { const int n = rho >> 4, i = rho & 15; return 8 * (i >> 2) + 4 * n + (i & 3); }

struct Unit { int pm, pn; };
struct Gemm { const bf16_t* A; const bf16_t* Bt; int M, N, K; };

struct StaticOrder {
    int nM, nN, nwg, G, c;
    __host__ __device__ void init(int M, int N, int G_, int c_) { nM = M / BM; nN = N / BM; nwg = nM * nN; G = G_; c = c_; }
    __host__ __device__ bool next(int i, Unit& u) const {
        const long L = (long)i * G + c; if (L >= nwg) return false;
        int wgid = (int)L; { const int q = nwg / NXCD, r = nwg % NXCD, xcd = wgid % NXCD, off = wgid / NXCD; wgid = (xcd < r ? xcd * (q + 1) : r * (q + 1) + (xcd - r) * q) + off; }
        const int nig = WGM * nN, gid = wgid / nig, fm = gid * WGM, gsz = (nM - fm) < WGM ? (nM - fm) : WGM;
        u.pm = fm + ((wgid % nig) % gsz); u.pn = (wgid % nig) / gsz; return true;
    }
    __device__ __forceinline__ void a_ready(const Unit&) const {}
    __device__ __forceinline__ void done(const Unit&) const {}
};

__device__ __forceinline__ unsigned cvt_pk_bf16(float lo, float hi) { unsigned r; asm volatile("v_cvt_pk_bf16_f32 %0, %1, %2" : "=v"(r) : "v"(lo), "v"(hi)); return r; }
typedef float f32x2 __attribute__((ext_vector_type(2)));
__device__ __forceinline__ float sigmoidf_(float x) { return 1.0f / (1.0f + __expf(-x)); }
__device__ __forceinline__ float bf2f(bf16_t v) { return __uint_as_float(((unsigned)v) << 16); }
struct EpiSwiglu {
    static constexpr bool PERM = true, AFTER_DRAIN = false;
    bf16_t* O; int ldc;
    __device__ __forceinline__ void operator()(const f32x4 (&acc)[2][2][4][2], const Unit& u, int wr, int wc, int fr, int fq) const {
        const int row0 = u.pm * BM + wr * 64 + fr, col0 = u.pn * HALF + wc * 32 + 8 * fq;
#pragma unroll
        for (int ai = 0; ai < 2; ++ai)
#pragma unroll
            for (int m = 0; m < 4; ++m) { bf16_t* rowp = O + (size_t)(row0 + ai * HALF + m * 16) * ldc + col0;
                float o[8];
#pragma unroll
                for (int n = 0; n < 2; ++n)
#pragma unroll
                    for (int i = 0; i < 4; ++i) { const float g = acc[ai][0][m][n][i], up = acc[ai][1][m][n][i]; o[4 * n + i] = g * sigmoidf_(g) * up; }
                u32x4 w; w.x = cvt_pk_bf16(o[0], o[1]); w.y = cvt_pk_bf16(o[2], o[3]); w.z = cvt_pk_bf16(o[4], o[5]); w.w = cvt_pk_bf16(o[6], o[7]);
                *(u32x4*)rowp = w; }
    }
};
struct EpiF32 {
    static constexpr bool PERM = false, AFTER_DRAIN = false;
    float* O; int ldc;
    __device__ __forceinline__ void operator()(const f32x4 (&acc)[2][2][4][2], const Unit& u, int wr, int wc, int fr, int fq) const {
        const int row0 = u.pm * BM + wr * 64 + fr, col0 = u.pn * BM + wc * 32 + 4 * fq;
#pragma unroll
        for (int ai = 0; ai < 2; ++ai)
#pragma unroll
            for (int m = 0; m < 4; ++m) { float* rowp = O + (size_t)(row0 + ai * HALF + m * 16) * ldc + col0;
#pragma unroll
                for (int bj = 0; bj < 2; ++bj)
#pragma unroll
                    for (int n = 0; n < 2; ++n) *(f32x4*)(rowp + bj * HALF + n * 16) = acc[ai][bj][m][n]; }
    }
};
struct EpiBf16Plain {
    static constexpr bool PERM = true, AFTER_DRAIN = false;
    bf16_t* O; int ldc;
    __device__ __forceinline__ void operator()(const f32x4 (&acc)[2][2][4][2], const Unit& u, int wr, int wc, int fr, int fq) const {
        const int row0 = u.pm * BM + wr * 64 + fr, col0 = u.pn * BM + wc * 32 + 8 * fq;
#pragma unroll
        for (int ai = 0; ai < 2; ++ai)
#pragma unroll
            for (int m = 0; m < 4; ++m) { bf16_t* rowp = O + (size_t)(row0 + ai * HALF + m * 16) * ldc + col0;
#pragma unroll
                for (int bj = 0; bj < 2; ++bj) { const f32x4 v0 = acc[ai][bj][m][0], v1 = acc[ai][bj][m][1];
                    u32x4 w; w.x = cvt_pk_bf16(v0[0], v0[1]); w.y = cvt_pk_bf16(v0[2], v0[3]); w.z = cvt_pk_bf16(v1[0], v1[1]); w.w = cvt_pk_bf16(v1[2], v1[3]);
                    *(u32x4*)(rowp + bj * HALF) = w; } }
    }
};
struct EpiProj {
    static constexpr bool PERM = true, AFTER_DRAIN = false;
    bf16_t *Prw, *Qs, *Ks, *VTs, *Qm, *Gt; const float* gate_b; const float *cosT, *sinT; int row_off;
    __device__ __forceinline__ void operator()(const f32x4 (&acc)[2][2][4][2], const Unit& u, int wr, int wc, int fr, int fq) const {
        bf16_t* base; int ldc, colt; const int pn = u.pn; bool gate = false; float scale = 1.0f;
        if (pn < 7) { base = Prw; ldc = 1792; colt = 256 * pn; }
        else if (pn < 9) { base = Qs; ldc = 512; colt = 256 * (pn - 7); scale = 0.125f; }
        else if (pn < 10) { base = Ks; ldc = 128; colt = 0; }
        else if (pn < 12) { base = Qm; ldc = 512; colt = 256 * (pn - 10); scale = 0.08838834764831845f; }
        else { base = Gt; ldc = 3072; colt = 256 * (pn - 12); gate = true; }
        const bool rope_tile = (pn >= 7 && pn < 10) && ((wc & 1) == 0);
        const int row0 = u.pm * BM + wr * 64 + fr, col0 = colt + wc * 32 + 8 * fq;
        f32x4 bv[2][2];
#pragma unroll
        for (int bj = 0; bj < 2; ++bj)
#pragma unroll
            for (int n = 0; n < 2; ++n) bv[bj][n] = gate ? *(const f32x4*)(gate_b + col0 + bj * HALF + 4 * n) : (f32x4){0.f, 0.f, 0.f, 0.f};
#pragma unroll
        for (int ai = 0; ai < 2; ++ai)
#pragma unroll
            for (int m = 0; m < 4; ++m) { const int r = row0 + ai * HALF + m * 16; bf16_t* rowp = base + (size_t)r * ldc + col0;
                f32x4 c0 = (f32x4){1.f, 1.f, 1.f, 1.f}, c1 = c0, s0 = (f32x4){0.f, 0.f, 0.f, 0.f}, s1 = s0;
                if (rope_tile) { const float* ct = cosT + (size_t)(row_off + r) * 8; const float* st = sinT + (size_t)(row_off + r) * 8;
                    c0 = *(const f32x4*)ct; c1 = *(const f32x4*)(ct + 4); s0 = *(const f32x4*)st; s1 = *(const f32x4*)(st + 4); }
#pragma unroll
                for (int bj = 0; bj < 2; ++bj) { f32x4 v0 = acc[ai][bj][m][0] + bv[bj][0], v1 = acc[ai][bj][m][1] + bv[bj][1];
                    if (gate) {
#pragma unroll
                        for (int i = 0; i < 4; ++i) { v0[i] = sigmoidf_(v0[i]); v1[i] = sigmoidf_(v1[i]); } }
                    if (pn == 9 && bj == 1) {
                        const int cv = wc * 32 + 8 * fq, hkv = cv >> 6, d0 = cv & 63, b = r >> 12, t = r & 4095;
                        bf16_t* vt = VTs + ((size_t)((b * 2 + hkv) * 64 + d0)) * 4096 + t;
#pragma unroll
                        for (int i = 0; i < 4; ++i) { vt[(size_t)i * 4096] = (bf16_t)(cvt_pk_bf16(v0[i], 0.f) & 0xffffu); vt[(size_t)(4 + i) * 4096] = (bf16_t)(cvt_pk_bf16(v1[i], 0.f) & 0xffffu); }
                        continue; }
                    if (rope_tile) {
                        f32x4 p0, p1;
#pragma unroll
                        for (int i = 0; i < 4; ++i) { p0[i] = __shfl_xor(v0[i], 16); p1[i] = __shfl_xor(v1[i], 16); }
                        if (fq == 0) { v0 = v0 * c0 - p0 * s0; v1 = v1 * c1 - p1 * s1; }
                        else if (fq == 1) { v0 = v0 * c0 + p0 * s0; v1 = v1 * c1 + p1 * s1; } }
                    v0 = v0 * scale; v1 = v1 * scale;
                    if (pn == 9) { const u32x4 w = (u32x4){cvt_pk_bf16(v0[0], v0[1]), cvt_pk_bf16(v0[2], v0[3]), cvt_pk_bf16(v1[0], v1[1]), cvt_pk_bf16(v1[2], v1[3])}; *(u32x4*)rowp = w; }
                    else { u32x4 w; w.x = cvt_pk_bf16(v0[0], v0[1]); w.y = cvt_pk_bf16(v0[2], v0[3]); w.z = cvt_pk_bf16(v1[0], v1[1]); w.w = cvt_pk_bf16(v1[2], v1[3]);
                        *(u32x4*)(rowp + bj * HALF) = w; } } }
    }
};
struct EpiMemKV {
    static constexpr bool PERM = true, AFTER_DRAIN = false;
    bf16_t *K, *VT;
    __device__ __forceinline__ void operator()(const f32x4 (&acc)[2][2][4][2], const Unit& u, int wr, int wc, int fr, int fq) const {
        const int row0 = u.pm * BM + wr * 64 + fr;
#pragma unroll
        for (int ai = 0; ai < 2; ++ai)
#pragma unroll
            for (int m = 0; m < 4; ++m) { const int r = row0 + ai * HALF + m * 16;
#pragma unroll
                for (int bj = 0; bj < 2; ++bj) { const f32x4 v0 = acc[ai][bj][m][0], v1 = acc[ai][bj][m][1]; const int col = u.pn * BM + bj * HALF + wc * 32 + 8 * fq;
                    if (u.pn < 2) { u32x4 w; w.x = cvt_pk_bf16(v0[0], v0[1]); w.y = cvt_pk_bf16(v0[2], v0[3]); w.z = cvt_pk_bf16(v1[0], v1[1]); w.w = cvt_pk_bf16(v1[2], v1[3]);
                        *(u32x4*)(K + (size_t)r * 512 + col) = w; }
                    else { const int cv = col - 512, h = cv >> 7, d0 = cv & 127, b = r >> 8, mm = r & 255;
                        bf16_t* vt = VT + ((size_t)((b * 4 + h) * 128 + d0)) * 256 + mm;
#pragma unroll
                        for (int i = 0; i < 4; ++i) { vt[(size_t)i * 256] = (bf16_t)(cvt_pk_bf16(v0[i], 0.f) & 0xffffu); vt[(size_t)(4 + i) * 256] = (bf16_t)(cvt_pk_bf16(v1[i], 0.f) & 0xffffu); } } } }
    }
};
struct EpiMerge {
    static constexpr bool PERM = true, AFTER_DRAIN = false;
    bf16_t* O; const bf16_t* G; int gcol; int first;
    __device__ __forceinline__ void operator()(const f32x4 (&acc)[2][2][4][2], const Unit& u, int wr, int wc, int fr, int fq) const {
        const int row0 = u.pm * BM + wr * 64 + fr, col0 = u.pn * BM + wc * 32 + 8 * fq;
#pragma unroll
        for (int ai = 0; ai < 2; ++ai)
#pragma unroll
            for (int m = 0; m < 4; ++m) { const size_t r = (size_t)(row0 + ai * HALF + m * 16);
#pragma unroll
                for (int bj = 0; bj < 2; ++bj) {
                    const u32x4 gw = *(const u32x4*)(G + r * 3072 + gcol + col0 + bj * HALF);
                    u32x4 ow = (u32x4){0u, 0u, 0u, 0u}; if (!first) ow = *(const u32x4*)(O + r * 1024 + col0 + bj * HALF);
                    float o[8];
#pragma unroll
                    for (int q = 0; q < 4; ++q) { const unsigned g2 = gw[q], o2 = ow[q];
                        const float a0 = acc[ai][bj][m][q >> 1][(q & 1) * 2], a1 = acc[ai][bj][m][q >> 1][(q & 1) * 2 + 1];
                        o[2 * q] = __uint_as_float(o2 << 16) + __uint_as_float(g2 << 16) * a0;
                        o[2 * q + 1] = __uint_as_float(o2 & 0xffff0000u) + __uint_as_float(g2 & 0xffff0000u) * a1; }
                    u32x4 w; w.x = cvt_pk_bf16(o[0], o[1]); w.y = cvt_pk_bf16(o[2], o[3]); w.z = cvt_pk_bf16(o[4], o[5]); w.w = cvt_pk_bf16(o[6], o[7]);
                    *(u32x4*)(O + r * 1024 + col0 + bj * HALF) = w; } }
    }
};
template <class Epi, class Sched, bool ALIGN_EPI = false, bool SP2 = false>
__device__ __forceinline__ void gemm_phase(PG8_LAS unsigned char* lds, const Gemm g, const Sched& S, const Epi& E) {
    int tid_ = threadIdx.x; asm volatile("" : "+v"(tid_));
    const int tid = tid_, wid = __builtin_amdgcn_readfirstlane(tid >> 6), lane = tid & 63, wr = wid >> 2, wc = wid & 3, fr = lane & 15, fq = lane >> 4;
    const int K = g.K, nt = K / BK;
    unsigned voffA[2], voffB[2];
#pragma unroll
    for (int i = 0; i < 2; ++i) { int R, C; stage_rc(tid * 16 + i * 8192, R, C); const int Rb = Epi::PERM ? ((R & ~31) + perm32(R & 31)) : R;
        voffA[i] = (unsigned)(R * K + C) * 2u; voffB[i] = (unsigned)(Rb * K + C) * 2u; }
    const size_t kstep = (size_t)(BK * 2);
    const size_t hstep = (size_t)HALF * K * 2;
    const size_t tstep = 2 * hstep;
    const unsigned ldsw = (unsigned)wid * 1024u;
    const int aoff = lds_byte(wr * 64 + fr, fq * 8), boff = lds_byte(wc * 32 + fr, fq * 8);
#define PG8_SA(b, h) (((b) * 2 + (h)) * HTB)
#define PG8_SB(b, h) ((4 + (b) * 2 + (h)) * HTB)
#define PG8_STAGE(bufoff, gbase, voff) do { _Pragma("unroll") for (int _i = 0; _i < 2; ++_i) \
        __builtin_amdgcn_global_load_lds((const unsigned*)((const char*)(gbase) + (voff)[_i]), (PG8_LAS unsigned*)(lds + (bufoff) + ldsw + _i * 8192), 16, 0, 0); } while (0)
#define PG8_LDA(dst, b, h) do { _Pragma("unroll") for (int m = 0; m < 4; ++m) _Pragma("unroll") for (int k = 0; k < 2; ++k) dst[m][k] = *(const PG8_LAS bf16x8*)(lds + PG8_SA(b, h) + aoff + m * 2048 + k * 1024); } while (0)
#define PG8_LDB(dst, b, h) do { _Pragma("unroll") for (int n = 0; n < 2; ++n) _Pragma("unroll") for (int k = 0; k < 2; ++k) dst[n][k] = *(const PG8_LAS bf16x8*)(lds + PG8_SB(b, h) + boff + n * 2048 + k * 1024); } while (0)
#define PG8_MMA(ai, bj, At, Bt) do { __builtin_amdgcn_s_setprio(1); _Pragma("unroll") for (int m = 0; m < 4; ++m) _Pragma("unroll") for (int n = 0; n < 2; ++n) _Pragma("unroll") for (int k = 0; k < 2; ++k) \
        acc[ai][bj][m][n] = __builtin_amdgcn_mfma_f32_16x16x32_bf16(Bt[n][k], At[m][k], acc[ai][bj][m][n], 0, 0, 0); __builtin_amdgcn_s_setprio(0); } while (0)
#define PG8_WAIT_V(n) asm volatile("s_waitcnt vmcnt(" #n ")" ::: "memory")
#define PG8_WAIT_L(n) asm volatile("s_waitcnt lgkmcnt(" #n ")" ::: "memory")
#define PG8_BAR __builtin_amdgcn_s_barrier()
#define PG8_SCHED __builtin_amdgcn_sched_barrier(0)
    Unit cur, nxt; int ui = 0;
    if (!S.next(0, cur)) return;
    f32x4 acc[2][2][4][2];
#pragma unroll
    for (int a = 0; a < 2; ++a)
#pragma unroll
        for (int b = 0; b < 2; ++b)
#pragma unroll
            for (int m = 0; m < 4; ++m)
#pragma unroll
                for (int n = 0; n < 2; ++n) acc[a][b][m][n] = (f32x4){0.f, 0.f, 0.f, 0.f};
    bf16x8 At[4][2], B0[2][2], B1[2][2];
    const char* cA = (const char*)g.A + (size_t)cur.pm * tstep; const char* cB = (const char*)g.Bt + (size_t)cur.pn * tstep;
    S.a_ready(cur);
    if constexpr (SP2) {
        PG8_STAGE(PG8_SB(0, 0), cB, voffB); PG8_STAGE(PG8_SB(0, 1), cB + hstep, voffB); PG8_STAGE(PG8_SA(0, 0), cA, voffA); PG8_STAGE(PG8_SA(0, 1), cA + hstep, voffA);
        if (wr == 1) PG8_BAR;
        PG8_WAIT_V(2); PG8_BAR;
        PG8_STAGE(PG8_SB(1, 0), cB + kstep, voffB); PG8_STAGE(PG8_SA(1, 0), cA + kstep, voffA); PG8_STAGE(PG8_SB(1, 1), cB + hstep + kstep, voffB);
        PG8_WAIT_V(6); PG8_BAR;
    } else {
        PG8_STAGE(PG8_SB(0, 0), cB, voffB); PG8_STAGE(PG8_SA(0, 0), cA, voffA); PG8_STAGE(PG8_SB(0, 1), cB + hstep, voffB); PG8_STAGE(PG8_SA(0, 1), cA + hstep, voffA);
        if (wr == 1) PG8_BAR;
        PG8_WAIT_V(4); PG8_BAR;
        PG8_STAGE(PG8_SB(1, 0), cB + kstep, voffB); PG8_STAGE(PG8_SA(1, 0), cA + kstep, voffA); PG8_STAGE(PG8_SB(1, 1), cB + hstep + kstep, voffB);
        PG8_WAIT_V(6); PG8_BAR;
    }
    for (;;) {
        const bool has_next = S.next(ui + 1, nxt);
        const char* nA = has_next ? (const char*)g.A + (size_t)nxt.pm * tstep : cA; const char* nB = has_next ? (const char*)g.Bt + (size_t)nxt.pn * tstep : cB;
        for (int t = 0; t < nt; t += 2) {
            const bool last = (t == nt - 2);
            const char* a1 = cA + (size_t)(t + 1) * kstep;
            const char* a2 = last ? nA : cA + (size_t)(t + 2) * kstep; const char* b2 = last ? nB : cB + (size_t)(t + 2) * kstep;
            const char* a3 = a2 + kstep; const char* b3 = b2 + kstep;
            if (last && has_next) S.a_ready(nxt);
            if constexpr (SP2) {
            PG8_LDB(B0, 0, 0); PG8_LDB(B1, 0, 1); PG8_SCHED; PG8_LDA(At, 0, 0); PG8_STAGE(PG8_SA(1, 1), a1 + hstep, voffA);
            PG8_WAIT_V(8); PG8_WAIT_L(0); PG8_BAR; PG8_MMA(0, 0, At, B0); PG8_MMA(0, 1, At, B1); PG8_BAR; PG8_SCHED;
            PG8_LDA(At, 0, 1); PG8_STAGE(PG8_SB(0, 0), b2, voffB); PG8_STAGE(PG8_SB(0, 1), b2 + hstep, voffB); PG8_STAGE(PG8_SA(0, 0), a2, voffA);
            PG8_WAIT_V(8); PG8_WAIT_L(0); PG8_BAR; PG8_MMA(1, 0, At, B0); PG8_MMA(1, 1, At, B1); PG8_BAR; PG8_SCHED;
            PG8_LDB(B0, 1, 0); PG8_LDB(B1, 1, 1); PG8_SCHED; PG8_LDA(At, 1, 0); PG8_STAGE(PG8_SA(0, 1), a2 + hstep, voffA);
            PG8_WAIT_V(8); PG8_WAIT_L(0); PG8_BAR; PG8_MMA(0, 0, At, B0); PG8_MMA(0, 1, At, B1); PG8_BAR; PG8_SCHED;
            PG8_LDA(At, 1, 1); PG8_STAGE(PG8_SB(1, 0), b3, voffB); PG8_STAGE(PG8_SB(1, 1), b3 + hstep, voffB); PG8_STAGE(PG8_SA(1, 0), a3, voffA);
            PG8_WAIT_V(8); PG8_WAIT_L(0); PG8_BAR; PG8_MMA(1, 0, At, B0); PG8_MMA(1, 1, At, B1); PG8_BAR; PG8_SCHED;
            } else {
            PG8_LDB(B0, 0, 0); PG8_SCHED; PG8_LDA(At, 0, 0); PG8_STAGE(PG8_SA(1, 1), a1 + hstep, voffA);
            PG8_WAIT_L(8); PG8_BAR; PG8_WAIT_L(0); PG8_MMA(0, 0, At, B0); PG8_BAR; PG8_SCHED;
            PG8_LDB(B1, 0, 1); PG8_STAGE(PG8_SB(0, 0), b2, voffB);
            PG8_BAR; PG8_WAIT_L(0); PG8_MMA(0, 1, At, B1); PG8_BAR;
            PG8_LDA(At, 0, 1); PG8_STAGE(PG8_SA(0, 0), a2, voffA);
            PG8_BAR; PG8_WAIT_L(0); PG8_MMA(1, 0, At, B0); PG8_BAR; PG8_SCHED;
            PG8_STAGE(PG8_SB(0, 1), b2 + hstep, voffB);
            PG8_WAIT_V(6); PG8_BAR; PG8_MMA(1, 1, At, B1); PG8_BAR;
            PG8_LDB(B0, 1, 0); PG8_SCHED; PG8_LDA(At, 1, 0); PG8_STAGE(PG8_SA(0, 1), a2 + hstep, voffA);
            PG8_WAIT_L(8); PG8_BAR; PG8_WAIT_L(0); PG8_MMA(0, 0, At, B0); PG8_BAR; PG8_SCHED;
            PG8_LDB(B1, 1, 1); PG8_STAGE(PG8_SB(1, 0), b3, voffB);
            PG8_BAR; PG8_WAIT_L(0); PG8_MMA(0, 1, At, B1); PG8_BAR;
            PG8_LDA(At, 1, 1); PG8_STAGE(PG8_SA(1, 0), a3, voffA);
            PG8_BAR; PG8_WAIT_L(0); PG8_MMA(1, 0, At, B0); PG8_BAR; PG8_SCHED;
            PG8_STAGE(PG8_SB(1, 1), b3 + hstep, voffB);
            PG8_WAIT_V(6); PG8_BAR; PG8_MMA(1, 1, At, B1); PG8_BAR;
            }
        }
        if constexpr (ALIGN_EPI) { if (wr == 0) PG8_BAR; }
        if constexpr (!Epi::AFTER_DRAIN) { E(acc, cur, wr, wc, fr, fq); S.done(cur); }
        if (!has_next) break;
#pragma unroll
        for (int a = 0; a < 2; ++a)
#pragma unroll
            for (int b = 0; b < 2; ++b)
#pragma unroll
                for (int m = 0; m < 4; ++m)
#pragma unroll
                    for (int n = 0; n < 2; ++n) acc[a][b][m][n] = (f32x4){0.f, 0.f, 0.f, 0.f};
        cur = nxt; cA = nA; cB = nB; ++ui;
        if constexpr (ALIGN_EPI) { if (wr == 1) PG8_BAR; }
    }
    PG8_WAIT_V(0);
    if constexpr (!ALIGN_EPI) { if (wr == 0) PG8_BAR; }
    PG8_BAR;
    if constexpr (Epi::AFTER_DRAIN) { E.fused(acc, cur, wr, wc, fr, fq, lds, wid, lane); S.done(cur); }
#undef PG8_SA
#undef PG8_SB
#undef PG8_STAGE
#undef PG8_LDA
#undef PG8_LDB
#undef PG8_MMA
#undef PG8_WAIT_V
#undef PG8_WAIT_L
#undef PG8_BAR
#undef PG8_SCHED
}
}

#ifndef PG8_SP2
#define PG8_SP2 true
#endif
#ifndef PG8_ALIGN
#define PG8_ALIGN true
#endif

constexpr int NWAVES = 8;
constexpr int BATCH = 8, SEQ = 4096, D = 1024, DFF = 2816, MTOK = BATCH * SEQ;
constexpr int MH = MTOK / 2;
constexpr int MEML = 256, MEMROWS = BATCH * MEML;
constexpr int INCOLS = 6144;
constexpr size_t MiB = 1u << 20;
constexpr size_t WS_CTL = 0, CTL_ZERO_BYTES = 1 * MiB;
constexpr size_t WS_W1A = 2 * MiB, WS_W2A = 13 * MiB, WS_W1B = 19 * MiB, WS_W2B = 30 * MiB, WS_WIN = 36 * MiB, WS_WKV = 48 * MiB, WS_WBR = 50 * MiB, WS_WOUT = 53 * MiB;
constexpr size_t WS_MEMN = 55 * MiB, WS_KVM = 59 * MiB, WS_COS = 63 * MiB, WS_SIN = 64 * MiB;
constexpr size_t WS_LORA = 65 * MiB;
constexpr size_t LORA_A = 65536, LORA_G = 131072;
constexpr size_t WS_XN = 66 * MiB;
constexpr size_t RO_REC = 0, RO_G = 96 * MiB, RO_VS = 112 * MiB, RO_BONUS = 128 * MiB;
constexpr int PSTR = 3600;
constexpr size_t WS_X = 130 * MiB;
constexpr size_t WS_R = 322 * MiB;
constexpr size_t WS_Y = 462 * MiB;
constexpr size_t WS_END = 510 * MiB;
constexpr size_t XO_PRW = 0, XO_QS = 56 * MiB, XO_KVS = 72 * MiB, XO_QM = 80 * MiB, XO_GT = 96 * MiB;
constexpr int CW_BAR = 4096;

constexpr int RING_OFF = 0, RING_BYTES = 131072;
constexpr int LDSCTL_OFF = RING_BYTES, MISC_OFF = LDSCTL_OFF + 320;
constexpr int LDS_BYTES = 147456;
#define GAS __attribute__((address_space(1)))
#define LAS __attribute__((address_space(3)))
typedef unsigned short bf16;
typedef unsigned v4u __attribute__((ext_vector_type(4)));
typedef float f32x4 __attribute__((ext_vector_type(4)));
typedef short bf16x8 __attribute__((ext_vector_type(8)));
typedef GAS unsigned gu32;
typedef GAS unsigned long long gu64;
#define RLX_AGENT __ATOMIC_RELAXED, __HIP_MEMORY_SCOPE_AGENT
#define LDS_WAIT() asm volatile("s_waitcnt lgkmcnt(0)" ::: "memory")
#define VM_WAIT() asm volatile("s_waitcnt vmcnt(0)" ::: "memory")
__device__ __forceinline__ unsigned long long rt() { return __builtin_amdgcn_s_memrealtime(); }
__device__ __forceinline__ unsigned f2bf(float f) { unsigned u = __builtin_bit_cast(unsigned, f); return (u + 0x7fffu + ((u >> 16) & 1u)) >> 16; }
__device__ __forceinline__ unsigned pk2(float lo, float hi) { return f2bf(lo) | (f2bf(hi) << 16); }

#define XB_TMO      128
#define XB_XCNT(j)  (256  + 64 * (j))
#define XB_XSUB(j)  (1280 + 64 * (j))
#define XB_XGEN(j)  (2304 + 64 * (j))
#define XB_TOP      3328
#define XB_TOPGEN   3392
#define XCD_BAR_WORDS 3456
#define XB_SPIN_CAP (1u << 18)

__device__ __forceinline__ unsigned xb_ld(unsigned* p)              { return __hip_atomic_load(p, __ATOMIC_RELAXED, __HIP_MEMORY_SCOPE_AGENT); }
__device__ __forceinline__ unsigned xb_add(unsigned* p, unsigned v) { return __hip_atomic_fetch_add(p, v, __ATOMIC_RELAXED, __HIP_MEMORY_SCOPE_AGENT); }
__device__ __forceinline__ unsigned xb_xcc_id() { return (unsigned)__builtin_amdgcn_s_getreg((3 << 11) | 20) & 0xFu; }
#define XB_SPIN(cond, bar) do { unsigned _sp = 0; while (cond) { __builtin_amdgcn_s_sleep(1); \
    if ((++_sp & 255u) == 0u) { if (xb_ld(&(bar)[XB_TMO])) break; if (_sp > XB_SPIN_CAP) { atomicAdd(&(bar)[XB_TMO], 1u); break; } } } } while (0)

struct XcdBarrier {
    unsigned* bar; unsigned x;
    volatile LAS unsigned* st;
};

__device__ __forceinline__ XcdBarrier xcd_barrier_post(unsigned* bar, volatile LAS unsigned* st) {
    XcdBarrier b; b.bar = bar; b.x = xb_xcc_id(); b.st = st;
    if (threadIdx.x == 0) (void)xb_add(&bar[XB_XCNT(b.x)], 1u);
    return b;
}
__device__ __forceinline__ void xcd_barrier_complete(unsigned* bar, unsigned x, unsigned& nloc, unsigned& nx) {
    const unsigned G = gridDim.x * gridDim.y * gridDim.z;
    unsigned sum, cnt, mine, sp = 0u;
    for (;;) {
        sum = 0u; cnt = 0u; mine = 0u;
#pragma unroll
        for (unsigned j = 0; j < 16; ++j) { const unsigned c = xb_ld(&bar[XB_XCNT(j)]); sum += c; cnt += (c > 0u) ? 1u : 0u; mine = (j == x) ? c : mine; }
        if (sum == G) break;
        __builtin_amdgcn_s_sleep(1);
        if ((++sp & 255u) == 0u) { if (xb_ld(&bar[XB_TMO])) break; if (sp > XB_SPIN_CAP) { atomicAdd(&bar[XB_TMO], 1u); break; } }
    }
    nloc = mine > 0u ? mine : 1u; nx = cnt > 0u ? cnt : 1u;
}

__device__ __forceinline__ void xcd_barrier(const XcdBarrier& b) {
    asm volatile("s_waitcnt vmcnt(0)" ::: "memory");
    __syncthreads();
    if (threadIdx.x == 0) {
        unsigned* bar = b.bar;
        __builtin_amdgcn_s_waitcnt(0);
        unsigned nloc = b.st[0], nx = b.st[1];
        if (nloc == 0u) { xcd_barrier_complete(bar, b.x, nloc, nx); b.st[0] = nloc; b.st[1] = nx; }
        const unsigned old = xb_add(&bar[XB_XSUB(b.x)], 1u);
        const unsigned gen = old / nloc;
        if (old + 1u == (gen + 1u) * nloc) {
            __builtin_amdgcn_fence(__ATOMIC_RELEASE, "agent");
            asm volatile("s_waitcnt vmcnt(0)" ::: "memory");
            const unsigned og = xb_add(&bar[XB_TOP], 1u);
            const unsigned tg = og / nx;
            if (og + 1u == (tg + 1u) * nx) xb_add(&bar[XB_TOPGEN], 1u);
            else XB_SPIN(xb_ld(&bar[XB_TOPGEN]) == tg, bar);
            __builtin_amdgcn_fence(__ATOMIC_ACQUIRE, "agent");
            xb_add(&bar[XB_XGEN(b.x)], 1u);
            asm volatile("s_waitcnt vmcnt(0)" ::: "memory");
        } else {
            XB_SPIN(xb_ld(&bar[XB_XGEN(b.x)]) == gen, bar);
            __builtin_amdgcn_fence(__ATOMIC_ACQUIRE, "agent");
            asm volatile("s_waitcnt vmcnt(0)" ::: "memory");
        }
    }
    __syncthreads();
}

struct Frame {
    LAS unsigned char* lds;
    volatile LAS unsigned* MISC;
    gu32* ctl;
    int tid, lane, wave;
    int vcu, G;
};
__device__ __forceinline__ float wave_sum(float v) {
#pragma unroll
    for (int o = 1; o < 64; o <<= 1) v += __shfl_xor(v, o);
    return v;
}
__device__ __forceinline__ float bf2f(bf16 v) { return __uint_as_float(((unsigned)v) << 16); }
__device__ __forceinline__ float sigm(float x) { return 1.0f / (1.0f + __expf(-x)); }

__device__ __forceinline__ void p0_transpose_item(const float* W, int K, int N, bf16* WT, int k0, int n0, int drow0, LAS float* scr, int lane) {
#pragma unroll 8
    for (int i = 0; i < 32; ++i) { const int kk = 2 * i + (lane >> 5); scr[kk * 33 + (lane & 31)] = W[(size_t)(k0 + kk) * N + n0 + (lane & 31)]; }
    LDS_WAIT(); asm volatile("" ::: "memory");
    const int c = lane & 7;
#pragma unroll
    for (int j = 0; j < 4; ++j) { const int n = (lane >> 3) + 8 * j; const LAS float* s = scr + (8 * c) * 33 + n;
        v4u o; o.x = pk2(s[0 * 33], s[1 * 33]); o.y = pk2(s[2 * 33], s[3 * 33]); o.z = pk2(s[4 * 33], s[5 * 33]); o.w = pk2(s[6 * 33], s[7 * 33]);
        *(GAS v4u*)(WT + (size_t)(drow0 + n) * K + k0 + 8 * c) = o; }
    LDS_WAIT(); asm volatile("" ::: "memory");
}
template <bool SWIGLU>
__device__ __forceinline__ void p0_transpose(const float* W, int K, int N, bf16* WT, LAS float* scr, int gw, int NGW, int lane) {
    const int nblk = N / 32, nitems = (K / 64) * nblk;
    for (int it = gw; it < nitems; it += NGW) {
        const int kb = it / nblk, nb = it % nblk, n0 = 32 * nb; int drow0 = n0;
        if (SWIGLU) { const int up = n0 >= DFF, j = up ? n0 - DFF : n0; drow0 = 256 * (j / 128) + 128 * up + (j % 128); }
        p0_transpose_item(W, K, N, WT, 64 * kb, n0, drow0, scr, lane);
    }
}
__device__ __forceinline__ void rms_row_to_bf16(const float* xrow, const float* g, bf16* orow, int lane) {
    const GAS f32x4* xr = (const GAS f32x4*)xrow + lane; const GAS f32x4* gr = (const GAS f32x4*)g + lane;
    f32x4 v[4]; float s = 0.f;
#pragma unroll
    for (int j = 0; j < 4; ++j) { v[j] = xr[64 * j]; s += (v[j].x * v[j].x + v[j].y * v[j].y) + (v[j].z * v[j].z + v[j].w * v[j].w); }
    const float r = 1.0f / sqrtf(wave_sum(s) * (1.f / D) + 1e-6f);
    GAS unsigned long long* o8 = (GAS unsigned long long*)orow + lane;
#pragma unroll
    for (int j = 0; j < 4; ++j) { const f32x4 gg = gr[64 * j]; o8[64 * j] = (unsigned long long)pk2(v[j].x * r * gg.x, v[j].y * r * gg.y) | ((unsigned long long)pk2(v[j].z * r * gg.z, v[j].w * r * gg.w) << 32); }
}
__device__ __forceinline__ void norm_res_row(const float* Frow, const float* base, float alpha, const float* g1, float* hout, const float* g2, bf16* xn, int lane) {
    const GAS f32x4* fr = (const GAS f32x4*)Frow + lane; const GAS f32x4* br = (const GAS f32x4*)base + lane; const GAS f32x4* g1r = (const GAS f32x4*)g1 + lane;
    f32x4 v[4], b[4]; float s = 0.f;
#pragma unroll
    for (int j = 0; j < 4; ++j) { v[j] = fr[64 * j]; b[j] = br[64 * j]; s += (v[j].x * v[j].x + v[j].y * v[j].y) + (v[j].z * v[j].z + v[j].w * v[j].w); }
    const float r = alpha / sqrtf(wave_sum(s) * (1.f / D) + 1e-6f); float s2 = 0.f;
#pragma unroll
    for (int j = 0; j < 4; ++j) { const f32x4 gg = g1r[64 * j]; v[j] = b[j] + v[j] * r * gg; s2 += (v[j].x * v[j].x + v[j].y * v[j].y) + (v[j].z * v[j].z + v[j].w * v[j].w); }
    GAS f32x4* ho = (GAS f32x4*)hout + lane;
#pragma unroll
    for (int j = 0; j < 4; ++j) ho[64 * j] = v[j];
    if (xn) {
        const float r2 = 1.0f / sqrtf(wave_sum(s2) * (1.f / D) + 1e-6f); const GAS f32x4* g2r = (const GAS f32x4*)g2 + lane;
        GAS unsigned long long* o8 = (GAS unsigned long long*)xn + lane;
#pragma unroll
        for (int j = 0; j < 4; ++j) { const f32x4 gg = g2r[64 * j]; o8[64 * j] = (unsigned long long)pk2(v[j].x * r2 * gg.x, v[j].y * r2 * gg.y) | ((unsigned long long)pk2(v[j].z * r2 * gg.z, v[j].w * r2 * gg.w) << 32); }
    }
}

struct MixIn {
    const bf16 *Prw, *Qs, *Ks, *VTs, *Qm, *Km, *VTm; const float *cosT, *sinT;
    const float *mu, *w0, *w_up, *a0, *a_up, *g_up, *k_k, *k_a, *r_k, *gn_g, *gn_b, *sinks;
    bf16 *Ya, *Yb, *Yc; int half;
};
__device__ __forceinline__ float rl(float v, int k) { return __uint_as_float((unsigned)__builtin_amdgcn_readlane((int)__float_as_uint(v), k)); }
__device__ __forceinline__ void swa_naive_item(const MixIn& X, int m, int hq, int lane) {
    const int t = m & (SEQ - 1), bl = m >> 12, hkv = hq >> 2;
    const float q = bf2f(X.Qs[(size_t)m * 512 + hq * 64 + lane]);
    float mx = X.sinks[hq], l = 1.0f, o = 0.f;
    const int j0 = t >= 127 ? t - 127 : 0;
    for (int j = j0; j <= t; ++j) {
        const size_t kr = (size_t)(m - t + j);
        const float kx = bf2f(X.Ks[kr * 128 + hkv * 64 + lane]), vx = bf2f(X.VTs[((size_t)((bl * 2 + hkv) * 64 + lane)) * 4096 + j]);
        const float sc = wave_sum(q * kx);
        const float mn = fmaxf(mx, sc), f = __expf(mx - mn), p = __expf(sc - mn);
        l = l * f + p; o = o * f + p * vx; mx = mn;
    }
    X.Yb[(size_t)m * 512 + hq * 64 + lane] = (bf16)f2bf(o / l);
}
__device__ __forceinline__ void mem_naive_item(const MixIn& X, int m, int h, int lane) {
    const int bg = X.half * (BATCH / 2) + (m >> 12);
    const float q0 = bf2f(X.Qm[(size_t)m * 512 + h * 128 + lane]), q1 = bf2f(X.Qm[(size_t)m * 512 + h * 128 + 64 + lane]);
    float mx = -1e30f, l = 0.f, o0 = 0.f, o1 = 0.f;
    for (int j = 0; j < MEML; ++j) {
        const bf16* kr = X.Km + (size_t)(bg * MEML + j) * 512 + h * 128; const bf16* vt = X.VTm + ((size_t)((bg * 4 + h) * 128)) * 256 + j;
        const float sc = wave_sum(q0 * bf2f(kr[lane]) + q1 * bf2f(kr[64 + lane]));
        const float mn = fmaxf(mx, sc), f = __expf(mx - mn), p = __expf(sc - mn);
        l = l * f + p; o0 = o0 * f + p * bf2f(vt[(size_t)lane * 256]); o1 = o1 * f + p * bf2f(vt[(size_t)(64 + lane) * 256]); mx = mn;
    }
    X.Yc[(size_t)m * 512 + h * 128 + lane] = (bf16)f2bf(o0 / l); X.Yc[(size_t)m * 512 + h * 128 + 64 + lane] = (bf16)f2bf(o1 / l);
}

typedef float f32x16_t __attribute__((ext_vector_type(16)));
typedef short s16x4_t __attribute__((ext_vector_type(4)));
__device__ __forceinline__ int crow(int r, int hi) { return (r & 3) + 8 * (r >> 2) + 4 * hi; }
__device__ __forceinline__ bf16x8 pack8r(const f32x16_t& p, int s) { v4u w; w.x = pk2(p[8 * s], p[8 * s + 1]); w.y = pk2(p[8 * s + 2], p[8 * s + 3]); w.z = pk2(p[8 * s + 4], p[8 * s + 5]); w.w = pk2(p[8 * s + 6], p[8 * s + 7]); return __builtin_bit_cast(bf16x8, w); }
__device__ __forceinline__ bf16x8 vt_frag(const bf16* vrow, int s, int hi) {
    const s16x4_t a = *(const GAS s16x4_t*)(vrow + 16 * s + 4 * hi), b = *(const GAS s16x4_t*)(vrow + 16 * s + 8 + 4 * hi);
    return (bf16x8){a[0], a[1], a[2], a[3], b[0], b[1], b[2], b[3]};
}
__device__ __forceinline__ void swa_mfma_unit(const MixIn& X, int bl, int hq, int t0, int lane) {
    const int r32 = lane & 31, hi = lane >> 5, hkv = hq >> 2; const size_t rowb = (size_t)bl * SEQ;
    bf16x8 qf[4];
#pragma unroll
    for (int ks = 0; ks < 4; ++ks) qf[ks] = *(const GAS bf16x8*)(X.Qs + (rowb + t0 + r32) * 512 + hq * 64 + 16 * ks + 8 * hi);
    f32x16_t S[5];
#pragma unroll
    for (int i = 0; i < 5; ++i) {
        const int kt0 = t0 - 128 + 32 * i;
#pragma unroll
        for (int r = 0; r < 16; ++r) S[i][r] = 0.f;
        if (kt0 >= 0) {
#pragma unroll
            for (int ks = 0; ks < 4; ++ks) { const bf16x8 kf = *(const GAS bf16x8*)(X.Ks + (rowb + kt0 + r32) * 128 + hkv * 64 + 16 * ks + 8 * hi);
                S[i] = __builtin_amdgcn_mfma_f32_32x32x16_bf16(kf, qf[ks], S[i], 0, 0, 0); }
        }
#pragma unroll
        for (int r = 0; r < 16; ++r) { const int cr = crow(r, hi); bool ok = kt0 >= 0;
            if (i == 0) ok = ok && (cr > r32);
            if (i == 4) ok = ok && (cr <= r32);
            if (!ok) S[i][r] = -1e30f; }
    }
    const float sink = X.sinks[hq];
    float mx = sink;
#pragma unroll
    for (int i = 0; i < 5; ++i)
#pragma unroll
        for (int r = 0; r < 16; ++r) mx = fmaxf(mx, S[i][r]);
    mx = fmaxf(mx, __shfl_xor(mx, 32));
    float l = 0.f;
#pragma unroll
    for (int i = 0; i < 5; ++i)
#pragma unroll
        for (int r = 0; r < 16; ++r) { const float p = __expf(S[i][r] - mx); S[i][r] = p; l += p; }
    l += __shfl_xor(l, 32); l += __expf(sink - mx);
    const float linv = 1.0f / l;
    f32x16_t O[2];
#pragma unroll
    for (int dt = 0; dt < 2; ++dt)
#pragma unroll
        for (int r = 0; r < 16; ++r) O[dt][r] = 0.f;
#pragma unroll
    for (int i = 0; i < 5; ++i) { const int kt0 = t0 - 128 + 32 * i;
        if (kt0 >= 0) {
#pragma unroll
            for (int s2 = 0; s2 < 2; ++s2) { const bf16x8 pf = pack8r(S[i], s2);
#pragma unroll
                for (int dt = 0; dt < 2; ++dt) { const bf16x8 vf = vt_frag(X.VTs + ((size_t)((bl * 2 + hkv) * 64 + 32 * dt + r32)) * 4096 + kt0, s2, hi);
                    O[dt] = __builtin_amdgcn_mfma_f32_32x32x16_bf16(pf, vf, O[dt], 0, 0, 0); } } } }
#pragma unroll
    for (int r = 0; r < 16; ++r) { const int qr = crow(r, hi); const float li = __shfl(linv, qr);
#pragma unroll
        for (int dt = 0; dt < 2; ++dt) X.Yb[(rowb + t0 + qr) * 512 + hq * 64 + 32 * dt + r32] = (bf16)f2bf(O[dt][r] * li); }
}
__device__ __forceinline__ void mem_mfma_unit(const MixIn& X, int m0, int h, int lane) {
    const int r32 = lane & 31, hi = lane >> 5, bg = X.half * (BATCH / 2) + (m0 >> 12);
    bf16x8 qf[8];
#pragma unroll
    for (int ks = 0; ks < 8; ++ks) qf[ks] = *(const GAS bf16x8*)(X.Qm + (size_t)(m0 + r32) * 512 + h * 128 + 16 * ks + 8 * hi);
    const bf16* Kb = X.Km + ((size_t)bg * MEML + r32) * 512 + h * 128 + 8 * hi;
    float mx = -1e30f;
    for (int i = 0; i < 8; ++i) { f32x16_t S;
#pragma unroll
        for (int r = 0; r < 16; ++r) S[r] = 0.f;
#pragma unroll
        for (int ks = 0; ks < 8; ++ks) { const bf16x8 kf = *(const GAS bf16x8*)(Kb + (size_t)(32 * i) * 512 + 16 * ks); S = __builtin_amdgcn_mfma_f32_32x32x16_bf16(kf, qf[ks], S, 0, 0, 0); }
#pragma unroll
        for (int r = 0; r < 16; ++r) mx = fmaxf(mx, S[r]); }
    mx = fmaxf(mx, __shfl_xor(mx, 32));
    float l = 0.f; f32x16_t O[4];
#pragma unroll
    for (int dt = 0; dt < 4; ++dt)
#pragma unroll
        for (int r = 0; r < 16; ++r) O[dt][r] = 0.f;
    const bf16* Vb = X.VTm + ((size_t)((bg * 4 + h) * 128 + r32)) * 256;
    for (int i = 0; i < 8; ++i) { f32x16_t S;
#pragma unroll
        for (int r = 0; r < 16; ++r) S[r] = 0.f;
#pragma unroll
        for (int ks = 0; ks < 8; ++ks) { const bf16x8 kf = *(const GAS bf16x8*)(Kb + (size_t)(32 * i) * 512 + 16 * ks); S = __builtin_amdgcn_mfma_f32_32x32x16_bf16(kf, qf[ks], S, 0, 0, 0); }
#pragma unroll
        for (int r = 0; r < 16; ++r) { const float p = __expf(S[r] - mx); S[r] = p; l += p; }
#pragma unroll
        for (int s2 = 0; s2 < 2; ++s2) { const bf16x8 pf = pack8r(S, s2);
#pragma unroll
            for (int dt = 0; dt < 4; ++dt) { const bf16x8 vf = vt_frag(Vb + (size_t)(32 * dt) * 256 + 32 * i, s2, hi); O[dt] = __builtin_amdgcn_mfma_f32_32x32x16_bf16(pf, vf, O[dt], 0, 0, 0); } } }
    l += __shfl_xor(l, 32);
    const float linv = 1.0f / l;
#pragma unroll
    for (int r = 0; r < 16; ++r) { const int qr = crow(r, hi); const float li = __shfl(linv, qr);
#pragma unroll
        for (int dt = 0; dt < 4; ++dt) X.Yc[(size_t)(m0 + qr) * 512 + h * 128 + 32 * dt + r32] = (bf16)f2bf(O[dt][r] * li); }
}

struct PrepIn {
    const bf16* Prw; const float *mu, *w0, *a0, *k_k, *k_a, *r_k; const bf16 *w_upT, *a_upT, *g_upT;
    unsigned* REC; bf16 *G, *VS; float* BONUS;
};
typedef float f32x4_t __attribute__((ext_vector_type(4)));
__device__ __forceinline__ void prep_ld8(const LAS unsigned char* lds, int i, int col0, const float* mu, float (&xs)[8]) {
    const v4u c = *(const LAS v4u*)(lds + (i + 1) * PSTR + col0 * 2), p = *(const LAS v4u*)(lds + i * PSTR + col0 * 2);
    const f32x4_t m0 = *(const GAS f32x4_t*)(mu + col0), m1 = *(const GAS f32x4_t*)(mu + col0 + 4);
#pragma unroll
    for (int j = 0; j < 4; ++j) { const float cl = __uint_as_float(c[j] << 16), ch = __uint_as_float(c[j] & 0xffff0000u), pl = __uint_as_float(p[j] << 16), ph = __uint_as_float(p[j] & 0xffff0000u);
        const float ml = (j < 2 ? m0 : m1)[(2 * j) & 3], mh = (j < 2 ? m0 : m1)[(2 * j + 1) & 3];
        xs[2 * j] = cl + (pl - cl) * ml; xs[2 * j + 1] = ch + (ph - ch) * mh; }
}
__device__ __forceinline__ bf16x8 pack8(const float (&x)[8]) { v4u w; w.x = pk2(x[0], x[1]); w.y = pk2(x[2], x[3]); w.z = pk2(x[4], x[5]); w.w = pk2(x[6], x[7]); return __builtin_bit_cast(bf16x8, w); }
__device__ __forceinline__ void rwkv_prep_phase(Frame& F, const PrepIn& X) {
    const LAS unsigned char* L = F.lds + RING_OFF; const int lane = F.lane, n = lane & 15, q = lane >> 4, h = F.wave;
    for (int item = F.vcu; item < MH / 16; item += F.G) {
        const int r0 = item * 16;
        __syncthreads();
        for (int c = F.tid; c < 17 * 224; c += NWAVES * 64) { const int rr = c / 224, ch = c % 224; v4u val = (v4u){0u, 0u, 0u, 0u};
            if (!(rr == 0 && (r0 & (SEQ - 1)) == 0)) val = *(const GAS v4u*)(X.Prw + (size_t)(r0 - 1 + rr) * 1792 + ch * 8);
            *(LAS v4u*)(F.lds + RING_OFF + rr * PSTR + ch * 16) = val; }
        __syncthreads();
        bf16x8 Aw[2], Aa[2], Ag[4]; float xs[8];
#pragma unroll
        for (int ks = 0; ks < 2; ++ks) {
            prep_ld8(L, n, 1536 + 32 * ks + 8 * q, X.mu, xs);
#pragma unroll
            for (int j = 0; j < 8; ++j) xs[j] = tanhf(xs[j]);
            Aw[ks] = pack8(xs);
            prep_ld8(L, n, 1600 + 32 * ks + 8 * q, X.mu, xs); Aa[ks] = pack8(xs); }
#pragma unroll
        for (int ks = 0; ks < 4; ++ks) { prep_ld8(L, n, 1664 + 32 * ks + 8 * q, X.mu, xs);
#pragma unroll
            for (int j = 0; j < 8; ++j) xs[j] = sigm(xs[j]);
            Ag[ks] = pack8(xs); }
        f32x4_t cw[4], ca[4], cg[4];
#pragma unroll
        for (int nt = 0; nt < 4; ++nt) { cw[nt] = (f32x4_t){0.f, 0.f, 0.f, 0.f}; ca[nt] = cw[nt]; cg[nt] = cw[nt]; const int col = h * 64 + 16 * nt + n;
#pragma unroll
            for (int ks = 0; ks < 2; ++ks) { const bf16x8 bw = *(const GAS bf16x8*)(X.w_upT + (size_t)col * 64 + 32 * ks + 8 * q), ba = *(const GAS bf16x8*)(X.a_upT + (size_t)col * 64 + 32 * ks + 8 * q);
                cw[nt] = __builtin_amdgcn_mfma_f32_16x16x32_bf16(Aw[ks], bw, cw[nt], 0, 0, 0); ca[nt] = __builtin_amdgcn_mfma_f32_16x16x32_bf16(Aa[ks], ba, ca[nt], 0, 0, 0); }
#pragma unroll
            for (int ks = 0; ks < 4; ++ks) { const bf16x8 bg = *(const GAS bf16x8*)(X.g_upT + (size_t)col * 128 + 32 * ks + 8 * q);
                cg[nt] = __builtin_amdgcn_mfma_f32_16x16x32_bf16(Ag[ks], bg, cg[nt], 0, 0, 0); } }
        float kkv[4][4], ktv[4][4], rsv[4][4], asg[4][4], n2[4], bon[4];
#pragma unroll
        for (int reg = 0; reg < 4; ++reg) { n2[reg] = 0.f; bon[reg] = 0.f; }
#pragma unroll
        for (int nt = 0; nt < 4; ++nt) { const int col = h * 64 + 16 * nt + n;
            const float mu_r = X.mu[col], mu_k = X.mu[512 + col], mu_v = X.mu[1024 + col], w0 = X.w0[col], a0 = X.a0[col], k_k = X.k_k[col], k_a = X.k_a[col], r_k = X.r_k[col];
#pragma unroll
            for (int reg = 0; reg < 4; ++reg) { const int i = 4 * q + reg; const size_t row = (size_t)(r0 + i);
                const LAS bf16* cur = (const LAS bf16*)(L + (i + 1) * PSTR); const LAS bf16* prv = (const LAS bf16*)(L + i * PSTR);
                const float cr = bf2f(cur[col]), ck = bf2f(cur[512 + col]), cv = bf2f(cur[1024 + col]), pr = bf2f(prv[col]), pk = bf2f(prv[512 + col]), pv = bf2f(prv[1024 + col]);
                const float xr = cr + (pr - cr) * mu_r, xk = ck + (pk - ck) * mu_k, xv = cv + (pv - cv) * mu_v;
                const float decay = __expf(-0.6065306597126334f * sigm(w0 + cw[nt][reg])), asig = sigm(a0 + ca[nt][reg]);
                const float kkj = xk * k_k, kt = xk * (1.0f + (asig - 1.0f) * k_a);
                kkv[nt][reg] = kkj; ktv[nt][reg] = kt; rsv[nt][reg] = xr; asg[nt][reg] = asig; n2[reg] += kkj * kkj; bon[reg] += xr * kt * r_k;
                X.REC[(row * 8 + h) * 192 + 32 + 20 * ((16 * nt + n) >> 3) + ((16 * nt + n) & 7)] = __float_as_uint(decay);
                X.G[row * 512 + col] = (bf16)f2bf(cg[nt][reg]); X.VS[row * 512 + col] = (bf16)f2bf(xv); } }
#pragma unroll
        for (int reg = 0; reg < 4; ++reg) {
#pragma unroll
            for (int o = 1; o < 16; o <<= 1) { n2[reg] += __shfl_xor(n2[reg], o); bon[reg] += __shfl_xor(bon[reg], o); }
            const float inv = 1.0f / fmaxf(sqrtf(n2[reg]), 1e-12f); const size_t row = (size_t)(r0 + 4 * q + reg);
            if (n == 0) X.BONUS[row * 8 + h] = bon[reg];
            bf16* rec16 = (bf16*)(X.REC + (row * 8 + h) * 192);
#pragma unroll
            for (int nt = 0; nt < 4; ++nt) { const float kk = kkv[nt][reg] * inv; const int e = 16 * nt + n;
                const int gb = 2 * (32 + 20 * (e >> 3)) + (e & 7);
                rec16[e] = (bf16)f2bf(-kk); rec16[gb + 16] = (bf16)f2bf(kk * asg[nt][reg]); rec16[gb + 24] = (bf16)f2bf(ktv[nt][reg]); rec16[gb + 32] = (bf16)f2bf(rsv[nt][reg]); } }
    }
    __syncthreads();
}
typedef unsigned u32x16 __attribute__((ext_vector_type(16)));
struct ChunkIn { const unsigned* REC; const bf16* VS; bf16 *YL, *QT, *SL, *PC; };
__device__ __forceinline__ float bflo(unsigned d) { return __uint_as_float(d << 16); }
__device__ __forceinline__ float bfhi(unsigned d) { return __uint_as_float(d & 0xffff0000u); }
#define SLD16(dst, ptr, off) asm volatile("s_load_dwordx16 %0, %1, %2 glc" : "=s"(dst) : "s"(ptr), "i"(off))
#define SLD4(dst, ptr, off)  asm volatile("s_load_dwordx4 %0, %1, %2 glc" : "=s"(dst) : "s"(ptr), "i"(off))
__device__ __forceinline__ void fmac_s(float& acc, float sc, float x) { asm("v_fmac_f32_e32 %0, %1, %2" : "+v"(acc) : "s"(sc), "v"(x)); }
__device__ __forceinline__ float mul_s(float sc, float x) { float r; asm("v_mul_f32_e32 %0, %1, %2" : "=v"(r) : "s"(sc), "v"(x)); return r; }
__device__ __forceinline__ void fma_s(float& st, float sc, float u) { asm("v_fma_f32 %0, %0, %1, %2" : "+v"(st) : "s"(sc), "v"(u)); }
__device__ __forceinline__ void rwkv_chunk_phase(Frame& F, const ChunkIn& X) {
    const int lane = F.lane, NGW = F.G * NWAVES;
    for (int task = F.vcu * NWAVES + F.wave; task < (MH / SEQ) * 8 * 64; task += NGW) {
        const int bh = task >> 6, c = task & 63, bl = bh >> 3, h = bh & 7, hj = h * 64 + lane;
        const size_t row0 = (size_t)bl * SEQ + (size_t)c * 64;
        const unsigned* rc = X.REC + (row0 * 8 + h) * 192;
        { unsigned lo = __builtin_amdgcn_readfirstlane((unsigned)(size_t)rc), hi = __builtin_amdgcn_readfirstlane((unsigned)((size_t)rc >> 32)); rc = (const unsigned*)(((size_t)hi << 32) | lo); }
        float S[64], T[64];
#pragma unroll
        for (int k = 0; k < 64; ++k) { S[k] = 0.f; T[k] = (k == lane) ? 1.f : 0.f; }
        float vnext = bf2f(X.VS[row0 * 512 + hj]);
        u32x16 A0, A1, Gc; v4u Rc;
        SLD16(A0, rc, 0); SLD16(A1, rc, 64); SLD16(Gc, rc, 128); SLD4(Rc, rc, 192);
        for (int t = 0; t < 64; ++t) {
            const size_t row = row0 + t; float xv = vnext;
            if (t < 63) vnext = bf2f(X.VS[(row + 1) * 512 + hj]);
            asm volatile("s_waitcnt lgkmcnt(0)" : "+s"(A0), "+s"(A1), "+s"(Gc), "+s"(Rc));
            float sa0 = 0.f, sa1 = 0.f, ta0 = 0.f, ta1 = 0.f;
#pragma unroll
            for (int i = 0; i < 16; ++i) { const float al = bflo(A0[i]), ah = bfhi(A0[i]);
                fmac_s(sa0, al, S[2 * i]); fmac_s(ta0, al, T[2 * i]); fmac_s(sa1, ah, S[2 * i + 1]); fmac_s(ta1, ah, T[2 * i + 1]); }
#pragma unroll
            for (int i = 0; i < 16; ++i) { const float al = bflo(A1[i]), ah = bfhi(A1[i]);
                fmac_s(sa0, al, S[32 + 2 * i]); fmac_s(ta0, al, T[32 + 2 * i]); fmac_s(sa1, ah, S[33 + 2 * i]); fmac_s(ta1, ah, T[33 + 2 * i]); }
            const float sa = sa0 + sa1; float ta = ta0 + ta1;
            float y0 = 0.f, y1 = 0.f, q0 = 0.f, q1 = 0.f;
            const unsigned* rn = rc + 8 * 192;
#pragma unroll
            for (int g = 0; g < 8; ++g) {
                const u32x16 Gg = Gc; const v4u Rg = Rc;
                if (g < 7) asm volatile("s_load_dwordx16 %0, %4, %5 glc\n\ts_load_dwordx4 %1, %4, %6 glc" : "=&s"(Gc), "=&s"(Rc), "+v"(xv), "+v"(ta) : "s"(rc), "i"(128 + 80 * (g + 1)), "i"(192 + 80 * (g + 1)));
                else asm volatile("s_load_dwordx16 %0, %6, 0 glc\n\ts_load_dwordx16 %1, %6, 64 glc\n\ts_load_dwordx16 %2, %6, 128 glc\n\ts_load_dwordx4 %3, %6, 192 glc" : "=&s"(A0), "=&s"(A1), "=&s"(Gc), "=&s"(Rc), "+v"(xv), "+v"(ta) : "s"(rn));
#pragma unroll
                for (int i = 0; i < 4; ++i) { const int k = 8 * g + 2 * i;
                    const float w0 = __uint_as_float(Gg[2 * i]), w1 = __uint_as_float(Gg[2 * i + 1]), b0 = bflo(Gg[8 + i]), b1 = bfhi(Gg[8 + i]), k0 = bflo(Gg[12 + i]), k1 = bfhi(Gg[12 + i]), r0 = bflo(Rg[i]), r1 = bfhi(Rg[i]);
                    float u0 = mul_s(k0, xv); fmac_s(u0, b0, sa); fma_s(S[k], w0, u0); fmac_s(y0, r0, S[k]);
                    float u1 = mul_s(k1, xv); fmac_s(u1, b1, sa); fma_s(S[k + 1], w1, u1); fmac_s(y1, r1, S[k + 1]);
                    float z0 = mul_s(b0, ta); fma_s(T[k], w0, z0); fmac_s(q0, r0, T[k]);
                    float z1 = mul_s(b1, ta); fma_s(T[k + 1], w1, z1); fmac_s(q1, r1, T[k + 1]); }
                if (g < 7) asm volatile("s_waitcnt lgkmcnt(0)" : "+s"(Gc), "+s"(Rc), "+v"(y0), "+v"(y1), "+v"(q0), "+v"(q1));
            }
            X.YL[row * 512 + hj] = (bf16)f2bf(y0 + y1); X.QT[row * 512 + hj] = (bf16)f2bf(q0 + q1);
            rc = rn;
        }
        asm volatile("s_waitcnt lgkmcnt(0)" : "+s"(A0), "+s"(A1), "+s"(Gc), "+s"(Rc));
        v4u* sl = (v4u*)(X.SL + ((size_t)task * 64 + lane) * 64); v4u* pc = (v4u*)(X.PC + ((size_t)task * 64 + lane) * 64);
#pragma unroll
        for (int i = 0; i < 8; ++i) { v4u a, b;
            a.x = pk2(S[8 * i], S[8 * i + 1]); a.y = pk2(S[8 * i + 2], S[8 * i + 3]); a.z = pk2(S[8 * i + 4], S[8 * i + 5]); a.w = pk2(S[8 * i + 6], S[8 * i + 7]);
            b.x = pk2(T[8 * i], T[8 * i + 1]); b.y = pk2(T[8 * i + 2], T[8 * i + 3]); b.z = pk2(T[8 * i + 4], T[8 * i + 5]); b.w = pk2(T[8 * i + 6], T[8 * i + 7]);
            sl[i] = a; pc[i] = b; }
    }
}
struct CrossIn { const bf16 *SL, *PC; bf16* S0; };
__device__ __forceinline__ void rwkv_cross_phase(Frame& F, const CrossIn& X) {
    const int lane = F.lane, NGW = F.G * NWAVES;
    for (int task = F.vcu * NWAVES + F.wave; task < (MH / SEQ) * 8 * 64; task += NGW) {
        const int bh = task >> 6, v = task & 63;
        float s = 0.f;
        X.S0[(((size_t)bh * 64) * 64 + v) * 64 + lane] = (bf16)0;
        for (int c = 0; c < 63; ++c) {
            const bf16* P = X.PC + ((size_t)(bh * 64 + c) * 64) * 64 + lane;
            float acc0 = bf2f(X.SL[(((size_t)(bh * 64 + c)) * 64 + v) * 64 + lane]), acc1 = 0.f;
#pragma unroll
            for (int j = 0; j < 64; j += 2) { acc0 += rl(s, j) * bf2f(P[j * 64]); acc1 += rl(s, j + 1) * bf2f(P[(j + 1) * 64]); }
            s = acc0 + acc1;
            X.S0[(((size_t)(bh * 64 + c + 1)) * 64 + v) * 64 + lane] = (bf16)f2bf(s);
        }
    }
}
struct FinIn { const bf16 *YL, *QT, *S0, *G, *VS; const float *BONUS, *gn_g, *gn_b; bf16* Ya; };
__device__ __forceinline__ void rwkv_final_phase(Frame& F, const FinIn& X) {
    const int lane = F.lane, n = lane & 15, q = lane >> 4, NGW = F.G * NWAVES;
    for (int task = F.vcu * NWAVES + F.wave; task < (MH / SEQ) * 8 * 64; task += NGW) {
        const int bh = task >> 6, c = task & 63, bl = bh >> 3, h = bh & 7;
        const size_t row0 = (size_t)bl * SEQ + (size_t)c * 64;
        f32x4_t acc[4][4];
#pragma unroll
        for (int mt = 0; mt < 4; ++mt)
#pragma unroll
            for (int nt = 0; nt < 4; ++nt) acc[mt][nt] = (f32x4_t){0.f, 0.f, 0.f, 0.f};
        if (c > 0) {
#pragma unroll
            for (int ks = 0; ks < 2; ++ks) { bf16x8 a[4], b[4];
#pragma unroll
                for (int mt = 0; mt < 4; ++mt) a[mt] = *(const GAS bf16x8*)(X.QT + (row0 + 16 * mt + n) * 512 + h * 64 + 32 * ks + 8 * q);
#pragma unroll
                for (int nt = 0; nt < 4; ++nt) b[nt] = *(const GAS bf16x8*)(X.S0 + ((size_t)task * 64 + 16 * nt + n) * 64 + 32 * ks + 8 * q);
#pragma unroll
                for (int mt = 0; mt < 4; ++mt)
#pragma unroll
                    for (int nt = 0; nt < 4; ++nt) acc[mt][nt] = __builtin_amdgcn_mfma_f32_16x16x32_bf16(a[mt], b[nt], acc[mt][nt], 0, 0, 0); } }
        float gg[4], gb[4];
#pragma unroll
        for (int nt = 0; nt < 4; ++nt) { gg[nt] = X.gn_g[h * 64 + 16 * nt + n]; gb[nt] = X.gn_b[h * 64 + 16 * nt + n]; }
#pragma unroll
        for (int mt = 0; mt < 4; ++mt)
#pragma unroll
            for (int reg = 0; reg < 4; ++reg) { const size_t row = row0 + 16 * mt + 4 * q + reg; float y[4], sum = 0.f;
#pragma unroll
                for (int nt = 0; nt < 4; ++nt) { y[nt] = acc[mt][nt][reg] + bf2f(X.YL[row * 512 + h * 64 + 16 * nt + n]); sum += y[nt]; }
#pragma unroll
                for (int o = 1; o < 16; o <<= 1) sum += __shfl_xor(sum, o);
                const float mean = sum * (1.f / 64.f); float var = 0.f;
#pragma unroll
                for (int nt = 0; nt < 4; ++nt) { y[nt] -= mean; var += y[nt] * y[nt]; }
#pragma unroll
                for (int o = 1; o < 16; o <<= 1) var += __shfl_xor(var, o);
                const float rstd = 1.0f / sqrtf(var * (1.f / 64.f) + 64e-5f), bonus = X.BONUS[row * 8 + h];
#pragma unroll
                for (int nt = 0; nt < 4; ++nt) { const size_t e = row * 512 + h * 64 + 16 * nt + n;
                    const float yn = y[nt] * rstd * gg[nt] + gb[nt] + bonus * bf2f(X.VS[e]);
                    X.Ya[e] = (bf16)f2bf(yn * bf2f(X.G[e])); } }
    }
}

struct Args { const void* in[31]; float* out; unsigned char* ws; int ph_lo, ph_hi; };
constexpr int NSUB = 8, PH_MIX0 = 4, PH_FFN2 = PH_MIX0 + 2 * NSUB, NPH = PH_FFN2 + 3;
typedef __attribute__((address_space(4))) const unsigned char* kptr_t;
struct KA { kptr_t p;
    __device__ __forceinline__ const void* operator[](int i) const { return *(const void* const __attribute__((address_space(4)))*)(p + 8 * i); } };
struct ArgsView { KA in; float* out; unsigned char* ws; };
__device__ __forceinline__ ArgsView args_view() {
    kptr_t p = (kptr_t)__builtin_amdgcn_kernarg_segment_ptr(); asm volatile("" : "+s"(p));
    ArgsView a; a.in.p = p; a.out = (float*)a.in[31]; a.ws = (unsigned char*)a.in[32]; return a; }
extern __shared__ __attribute__((aligned(16))) unsigned char lds_dyn[];
__device__ __forceinline__ void frame_fill(Frame& F, const ArgsView& args) {
    F.lds = (LAS unsigned char*)lds_dyn;
    F.MISC = (volatile LAS unsigned*)(F.lds + MISC_OFF);
    { int t_ = threadIdx.x; asm volatile("" : "+v"(t_)); F.tid = t_; } F.lane = F.tid & 63; F.wave = __builtin_amdgcn_readfirstlane(F.tid >> 6);
    F.G = gridDim.x; { int bx = blockIdx.x; asm volatile("" : "+s"(bx)); F.vcu = (F.G % 8 == 0) ? (bx % 8) * (F.G / 8) + bx / 8 : bx; }
    F.ctl = (gu32*)(args.ws + WS_CTL);
}
__device__ __forceinline__ XcdBarrier bar_view() {
    const ArgsView args = args_view();
    XcdBarrier b; b.bar = (unsigned*)((gu32*)(args.ws + WS_CTL) + CW_BAR); b.x = xb_xcc_id(); b.st = (volatile LAS unsigned*)((LAS unsigned char*)lds_dyn + MISC_OFF) + 8; return b;
}
template <int PH>
__device__ __forceinline__ void run_phase() {
    const ArgsView args = args_view();
    Frame F; frame_fill(F, args);
    unsigned char* ws = args.ws;
    float* out = args.out;
    bf16* XN = (bf16*)(ws + WS_XN); bf16* HB = (bf16*)(ws + WS_X); float* FB = (float*)(ws + WS_R);
    bf16* PRW = (bf16*)(ws + WS_X + XO_PRW); bf16* QS = (bf16*)(ws + WS_X + XO_QS); bf16* KS = (bf16*)(ws + WS_X + XO_KVS); bf16* VTS = (bf16*)(ws + WS_X + XO_KVS + 4 * MiB); bf16* QM = (bf16*)(ws + WS_X + XO_QM); bf16* GT = (bf16*)(ws + WS_X + XO_GT);
    bf16* MERGED = (bf16*)(ws + WS_R); float* FH = (float*)(ws + WS_R + 32 * MiB);
    bf16* YA = (bf16*)(ws + WS_Y); bf16* YB = QS; bf16* YC = QM;
    bf16* SLB = (bf16*)(ws + WS_Y + 16 * MiB); bf16* PCB = (bf16*)(ws + WS_Y + 32 * MiB);
    bf16* YLB = (bf16*)(ws + WS_X + XO_PRW); bf16* QTB = (bf16*)(ws + WS_X + XO_PRW + 16 * MiB); bf16* S0B = (bf16*)(ws + WS_X + XO_PRW + 32 * MiB);
    bf16* WBR = (bf16*)(ws + WS_WBR); bf16* KVM = (bf16*)(ws + WS_KVM);
    const int gw = F.vcu * NWAVES + F.wave, NGW = F.G * NWAVES;
    if constexpr (PH == 0) {
        const float* x = (const float*)args.in[0]; const float* mem = (const float*)args.in[1]; const int* positions = (const int*)args.in[2];
        bf16* MEMN = (bf16*)(ws + WS_MEMN); float* COS = (float*)(ws + WS_COS); float* SIN = (float*)(ws + WS_SIN);
        LAS float* scr = (LAS float*)(F.lds + RING_OFF + F.wave * 16384);
        p0_transpose<true>((const float*)args.in[4], D, 2 * DFF, (bf16*)(ws + WS_W1A), scr, gw, NGW, F.lane);
        p0_transpose<false>((const float*)args.in[5], DFF, D, (bf16*)(ws + WS_W2A), scr, gw, NGW, F.lane);
        p0_transpose<true>((const float*)args.in[28], D, 2 * DFF, (bf16*)(ws + WS_W1B), scr, gw, NGW, F.lane);
        p0_transpose<false>((const float*)args.in[29], DFF, D, (bf16*)(ws + WS_W2B), scr, gw, NGW, F.lane);
        p0_transpose<false>((const float*)args.in[8], D, INCOLS, (bf16*)(ws + WS_WIN), scr, gw, NGW, F.lane);
        p0_transpose<false>((const float*)args.in[23], D, D, (bf16*)(ws + WS_WKV), scr, gw, NGW, F.lane);
        for (int br = 0; br < 3; ++br) p0_transpose<false>((const float*)args.in[24] + (size_t)br * 512 * D, 512, D, WBR + (size_t)br * D * 512, scr, gw, NGW, F.lane);
        p0_transpose<false>((const float*)args.in[25], D, D, (bf16*)(ws + WS_WOUT), scr, gw, NGW, F.lane);
        for (int m = gw; m < MTOK; m += NGW) rms_row_to_bf16(x + (size_t)m * D, (const float*)args.in[3], XN + (size_t)m * D, F.lane);
        for (int m = gw; m < MEMROWS; m += NGW) rms_row_to_bf16(mem + (size_t)m * D, (const float*)args.in[22], MEMN + (size_t)m * D, F.lane);
        { const float* w_up = (const float*)args.in[12]; const float* a_up = (const float*)args.in[14]; const float* g_up = (const float*)args.in[15];
          bf16* LW = (bf16*)(ws + WS_LORA); bf16* LA = (bf16*)(ws + WS_LORA + LORA_A); bf16* LG = (bf16*)(ws + WS_LORA + LORA_G);
          for (int i = blockIdx.x * (NWAVES * 64) + F.tid; i < 512 * 128; i += F.G * NWAVES * 64) {
              if (i < 512 * 64) { const int nn = i >> 6, kk = i & 63; LW[i] = (bf16)f2bf(w_up[kk * 512 + nn]); LA[i] = (bf16)f2bf(a_up[kk * 512 + nn]); }
              { const int nn = i >> 7, kk = i & 127; LG[i] = (bf16)f2bf(g_up[kk * 512 + nn]); } } }
        for (int i = blockIdx.x * (NWAVES * 64) + F.tid; i < MTOK * 8; i += F.G * NWAVES * 64) {
            const int tok = i >> 3, f = i & 7; const double inv = pow(500000.0, -(double)f / 8.0); const double ang = (double)positions[tok] * inv;
            COS[i] = (float)cos(ang); SIN[i] = (float)sin(ang); }
    } else if constexpr (PH == 1 || PH == PH_FFN2) {
        pg8::Gemm g{XN, (const bf16*)(ws + (PH == 1 ? WS_W1A : WS_W1B)), MTOK, 2 * DFF, D}; pg8::StaticOrder S; S.init(MTOK, 2 * DFF, F.G, (int)blockIdx.x);
        pg8::EpiSwiglu E{HB, DFF};
        pg8::gemm_phase<pg8::EpiSwiglu, pg8::StaticOrder, PG8_ALIGN, PG8_SP2>(F.lds + RING_OFF, g, S, E);
        if constexpr (PH == 1) {
            pg8::Gemm g2{(const bf16*)(ws + WS_MEMN), (const bf16*)(ws + WS_WKV), MEMROWS, D, D}; pg8::StaticOrder S2; S2.init(MEMROWS, D, F.G, (int)blockIdx.x);
            pg8::EpiMemKV E2{KVM, KVM + (size_t)MEMROWS * 512};
            pg8::gemm_phase<pg8::EpiMemKV, pg8::StaticOrder, PG8_ALIGN, PG8_SP2>(F.lds + RING_OFF, g2, S2, E2);
        }
    } else if constexpr (PH == 2 || PH == PH_FFN2 + 1) {
        pg8::Gemm g{HB, (const bf16*)(ws + (PH == 2 ? WS_W2A : WS_W2B)), MTOK, D, DFF}; pg8::StaticOrder S; S.init(MTOK, D, F.G, (int)blockIdx.x);
        pg8::EpiF32 E{FB, D};
        pg8::gemm_phase<pg8::EpiF32, pg8::StaticOrder, PG8_ALIGN, PG8_SP2>(F.lds + RING_OFF, g, S, E);
    } else if constexpr (PH == 3) {
        const float* x = (const float*)args.in[0];
        for (int m = gw; m < MTOK; m += NGW) norm_res_row(FB + (size_t)m * D, x + (size_t)m * D, 0.5f, (const float*)args.in[6], out + (size_t)m * D, (const float*)args.in[7], XN + (size_t)m * D, F.lane);
    } else if constexpr (PH == PH_FFN2 + 2) {
        for (int m = gw; m < MTOK; m += NGW) norm_res_row(FB + (size_t)m * D, out + (size_t)m * D, 0.5f, (const float*)args.in[30], out + (size_t)m * D, nullptr, nullptr, F.lane);
    } else {
        constexpr int hh = (PH - PH_MIX0) / NSUB, sub = (PH - PH_MIX0) % NSUB; constexpr size_t roff = (size_t)hh * MH;
        if constexpr (sub == 0) {
            pg8::Gemm g{XN + roff * D, (const bf16*)(ws + WS_WIN), MH, INCOLS, D}; pg8::StaticOrder S; S.init(MH, INCOLS, F.G, (int)blockIdx.x);
            pg8::EpiProj E{PRW, QS, KS, VTS, QM, GT, (const float*)args.in[9], (const float*)(ws + WS_COS), (const float*)(ws + WS_SIN), (int)roff};
            pg8::gemm_phase<pg8::EpiProj, pg8::StaticOrder, PG8_ALIGN, PG8_SP2>(F.lds + RING_OFF, g, S, E);
        } else if constexpr (sub == 1) {
            PrepIn X; X.Prw = PRW; X.mu = (const float*)args.in[10]; X.w0 = (const float*)args.in[11]; X.a0 = (const float*)args.in[13]; X.k_k = (const float*)args.in[16]; X.k_a = (const float*)args.in[17]; X.r_k = (const float*)args.in[18];
            X.w_upT = (const bf16*)(ws + WS_LORA); X.a_upT = (const bf16*)(ws + WS_LORA + LORA_A); X.g_upT = (const bf16*)(ws + WS_LORA + LORA_G);
            X.REC = (unsigned*)(ws + WS_R + RO_REC); X.G = (bf16*)(ws + WS_R + RO_G); X.VS = (bf16*)(ws + WS_R + RO_VS); X.BONUS = (float*)(ws + WS_R + RO_BONUS);
            rwkv_prep_phase(F, X);
        } else if constexpr (sub == 2) {
            ChunkIn X; X.REC = (const unsigned*)(ws + WS_R + RO_REC); X.VS = (const bf16*)(ws + WS_R + RO_VS); X.YL = YLB; X.QT = QTB; X.SL = SLB; X.PC = PCB;
            rwkv_chunk_phase(F, X);
        } else if constexpr (sub == 3) {
            { CrossIn Z; Z.SL = SLB; Z.PC = PCB; Z.S0 = S0B; rwkv_cross_phase(F, Z); }
            MixIn X; X.Prw = PRW; X.Qs = QS; X.Ks = KS; X.VTs = VTS; X.Qm = QM; X.Km = KVM; X.VTm = KVM + (size_t)MEMROWS * 512; X.cosT = (const float*)(ws + WS_COS); X.sinT = (const float*)(ws + WS_SIN);
            X.sinks = (const float*)args.in[21]; X.Ya = YA; X.Yb = YB; X.Yc = YC; X.half = hh;
            constexpr int NSWA = (MH / 32) * 8, NMEM = (MH / 32) * 4;
            for (int it = gw; it < NSWA + NMEM; it += NGW) {
                if (it < NSWA) { const int hq = it & 7, rb = it >> 3; swa_mfma_unit(X, rb >> 7, hq, (rb & 127) * 32, F.lane); }
                else { const int u = it - NSWA; mem_mfma_unit(X, (u >> 2) * 32, u & 3, F.lane); } }
        } else if constexpr (sub == 4) {
            FinIn Z; Z.YL = YLB; Z.QT = QTB; Z.S0 = S0B; Z.G = (const bf16*)(ws + WS_R + RO_G); Z.VS = (const bf16*)(ws + WS_R + RO_VS); Z.BONUS = (const float*)(ws + WS_R + RO_BONUS);
            Z.gn_g = (const float*)args.in[19]; Z.gn_b = (const float*)args.in[20]; Z.Ya = YA; rwkv_final_phase(F, Z);
        } else if constexpr (sub == 5) {
            for (int br = 0; br < 3; ++br) {
                pg8::Gemm g{br == 0 ? YA : (br == 1 ? YB : YC), WBR + (size_t)br * D * 512, MH, D, 512}; pg8::StaticOrder S; S.init(MH, D, F.G, (int)blockIdx.x);
                pg8::EpiMerge E{MERGED, GT, br * 1024, br == 0};
                pg8::gemm_phase<pg8::EpiMerge, pg8::StaticOrder, PG8_ALIGN, PG8_SP2>(F.lds + RING_OFF, g, S, E);
            }
        } else if constexpr (sub == 6) {
            pg8::Gemm g{MERGED, (const bf16*)(ws + WS_WOUT), MH, D, D}; pg8::StaticOrder S; S.init(MH, D, F.G, (int)blockIdx.x);
            pg8::EpiF32 E{FH, D};
            pg8::gemm_phase<pg8::EpiF32, pg8::StaticOrder, PG8_ALIGN, PG8_SP2>(F.lds + RING_OFF, g, S, E);
        } else {
            for (int m = gw; m < MH; m += NGW) norm_res_row(FH + (size_t)m * D, out + (roff + m) * D, 1.0f, (const float*)args.in[26], out + (roff + m) * D, (const float*)args.in[27], XN + (roff + m) * D, F.lane);
        }
    }
}
template <int PH>
__device__ __forceinline__ void run_from() {
    run_phase<PH>();
    if constexpr (PH + 1 < NPH) { xcd_barrier(bar_view()); run_from<PH + 1>(); }
}
__global__ void __launch_bounds__(NWAVES * 64, 2) fwd_all(Args args) {
    { LAS unsigned char* l = (LAS unsigned char*)lds_dyn;
      for (int u = threadIdx.x; u < (LDS_BYTES - LDSCTL_OFF) / 4; u += NWAVES * 64) ((LAS unsigned*)(l + LDSCTL_OFF))[u] = 0u;
      __syncthreads();
      const XcdBarrier b = bar_view(); (void)xcd_barrier_post(b.bar, b.st); }
    run_from<0>();
}

extern "C" void kernel_launch(void* const* d_in, const int* in_sizes, int n_in, void* d_out, int out_size, void* d_ws, size_t ws_size, hipStream_t stream) {
    static int grid = 0;
    if (grid == 0) {
        if (n_in != 31 || out_size != MTOK * D || ws_size < WS_END) { fprintf(stderr, "kernel_launch: unexpected shapes (n_in %d out %d ws %zu)\n", n_in, out_size, ws_size); grid = -1; return; }
        int dev = 0, cus = 0;
        if (hipGetDevice(&dev) != hipSuccess || hipDeviceGetAttribute(&cus, hipDeviceAttributeMultiprocessorCount, dev) != hipSuccess) { grid = -1; return; }
        if (hipFuncSetAttribute((const void*)fwd_all, hipFuncAttributeMaxDynamicSharedMemorySize, LDS_BYTES) != hipSuccess) { fprintf(stderr, "kernel_launch: hipFuncSetAttribute failed\n"); grid = -1; return; }
        (void)hipGetLastError();
        grid = cus;
    }
    if (grid < 0) return;
    (void)hipMemsetAsync((char*)d_ws + WS_CTL, 0, CTL_ZERO_BYTES, stream);
    Args a{};
    for (int i = 0; i < 31; ++i) a.in[i] = d_in[i];
    a.out = (float*)d_out; a.ws = (unsigned char*)d_ws; a.ph_lo = 0; a.ph_hi = NPH;
    hipLaunchKernelGGL(fwd_all, dim3(grid), dim3(NWAVES * 64), LDS_BYTES, stream, a);
}
```
